# Optimizing an MI355X kernel written in HIP

```python
import math
import jax, jax.numpy as jnp
from jax import lax
import numpy as np

D_MODEL = 2048
BATCH = 4
SEQ = 2048
DEPTH = 1
DEC_BATCH = 128
DEC_SEQ = 4
PAST_LEN = 16384
PAGE_SIZE = 128

SSM_EXPAND = 2
SSM_INNER = SSM_EXPAND * D_MODEL
SSM_HEADDIM = 64
SSM_HEADS = SSM_INNER // SSM_HEADDIM
SSM_GROUPS = 8
SSM_HPG = SSM_HEADS // SSM_GROUPS
SSM_STATE = 128
CONV_W = 4
CONV_DIM = SSM_INNER + 2 * SSM_GROUPS * SSM_STATE
RET_HEADS = 8
RET_QK = D_MODEL
RET_DK = RET_QK // RET_HEADS
RET_V = 2 * D_MODEL
RET_DV = RET_V // RET_HEADS
ROPE_BASE = 10000.0
CHUNK = 128
N_BRANCH = 2
EPS = 1e-6
IN_SIZES = (SSM_INNER, CONV_DIM, SSM_HEADS, RET_QK, RET_QK, RET_V, RET_V, N_BRANCH * D_MODEL)
IN_DIM = SSM_INNER + CONV_DIM + SSM_HEADS + 2 * RET_QK + 2 * RET_V + N_BRANCH * D_MODEL

kernel_name = "hybrid_ssd_retention_gated_merge_step"


def _rms(x):
    xf = x.astype(jnp.float32)
    return (xf * lax.rsqrt(jnp.mean(xf * xf, axis=-1, keepdims=True) + EPS)).astype(x.dtype)


def _rmsnorm(x, w):
    return _rms(x) * w.astype(x.dtype)


def _split_cols(t, sizes):
    offs = np.cumsum(np.array(sizes))[:-1].tolist()
    return jnp.split(t, offs, axis=-1)


def _rope(x, pos):
    half = x.shape[-1] // 2
    inv = 1.0 / (ROPE_BASE ** (jnp.arange(half, dtype=jnp.float32) / half))
    ang = pos.astype(jnp.float32)[:, None] * inv[None, :]
    cos = jnp.cos(ang)[None, :, None, :].astype(x.dtype)
    sin = jnp.sin(ang)[None, :, None, :].astype(x.dtype)
    x1, x2 = x[..., :half], x[..., half:]
    return jnp.concatenate([x1 * cos - x2 * sin, x2 * cos + x1 * sin], axis=-1)


def chunked_decay_scan(q, k, v, log_a, s0):
    b, L, G, N = q.shape
    R, P = v.shape[3], v.shape[4]
    Q = min(CHUNK, L)
    nc = -(-L // Q)
    pad = nc * Q - L
    cdt = v.dtype
    log_a = log_a.astype(jnp.float32)
    if pad:
        padf = lambda t: jnp.pad(t, [(0, 0), (0, pad)] + [(0, 0)] * (t.ndim - 2))
        q, k, v, log_a = padf(q), padf(k), padf(v), padf(log_a)
    q = q.reshape(b, nc, Q, G, N)
    k = k.reshape(b, nc, Q, G, N)
    v = v.reshape(b, nc, Q, G, R, P)
    log_a = log_a.reshape(b, nc, Q, G, R)
    a_cs = jnp.cumsum(log_a, axis=2)
    causal = jnp.tril(jnp.ones((Q, Q), dtype=bool))[None, None, :, :, None, None]
    seg = jnp.exp(jnp.where(causal, a_cs[:, :, :, None] - a_cs[:, :, None, :], -jnp.inf)).astype(cdt)
    qk = jnp.einsum('bclgn,bcsgn->bclsg', q, k)
    y_intra = jnp.einsum('bclsgr,bcsgrp->bclgrp', seg * qk[..., None], v)
    decay_end = jnp.exp(a_cs[:, :, -1:] - a_cs).astype(cdt)
    chunk_states = jnp.einsum('bclgn,bclgrp->bcgrpn', k, v * decay_end[..., None])
    chunk_decay = jnp.exp(a_cs[:, :, -1]).astype(cdt)

    def step(s, inp):
        dec, st = inp
        return dec[..., None, None] * s + st, s

    s_final, s_prev = lax.scan(step, s0.astype(cdt),
                               (jnp.moveaxis(chunk_decay, 1, 0), jnp.moveaxis(chunk_states, 1, 0)))
    y_inter = jnp.einsum('bclgn,cbgrpn->bclgrp', q, s_prev) * jnp.exp(a_cs).astype(cdt)[..., None]
    y = (y_intra + y_inter).reshape(b, nc * Q, G, R, P)[:, :L]
    return y, s_final


def mixer_layer(x, conv_buf, ssm_state, ret_state, pos0, w_pre, w_in, conv_w, conv_b, dt_bias,
                a_log, d_skip, ssm_norm_w, w_proj_ssm, w_proj_ret, w_out, w_post):
    b, L, _ = x.shape
    h = _rmsnorm(x, w_pre)
    proj = h @ w_in
    z, xbc, dt_raw, q, k, v, g, gates = _split_cols(proj, IN_SIZES)

    xbc_full = jnp.concatenate([conv_buf.astype(xbc.dtype), xbc], axis=1)
    new_conv = xbc_full[:, L:]
    conv = conv_b.astype(xbc.dtype)
    for tap in range(CONV_W):
        conv = conv + xbc_full[:, tap:tap + L] * conv_w[tap].astype(xbc.dtype)
    xbc_act = jax.nn.silu(conv)
    xs, bm, cm = _split_cols(xbc_act, (SSM_INNER, SSM_GROUPS * SSM_STATE, SSM_GROUPS * SSM_STATE))
    dt = jax.nn.softplus((dt_raw + dt_bias.astype(dt_raw.dtype)).astype(jnp.float32))
    a_neg = -jnp.exp(a_log.astype(jnp.float32))
    xs = xs.reshape(b, L, SSM_GROUPS, SSM_HPG, SSM_HEADDIM)
    dt_g = dt.reshape(b, L, SSM_GROUPS, SSM_HPG)
    y_ssm, ssm_new = chunked_decay_scan(
        cm.reshape(b, L, SSM_GROUPS, SSM_STATE),
        bm.reshape(b, L, SSM_GROUPS, SSM_STATE),
        xs * dt_g.astype(xs.dtype)[..., None],
        dt_g * a_neg.reshape(SSM_GROUPS, SSM_HPG),
        ssm_state.reshape(b, SSM_GROUPS, SSM_HPG, SSM_HEADDIM, SSM_STATE))
    y_ssm = y_ssm + xs * d_skip.astype(xs.dtype).reshape(SSM_GROUPS, SSM_HPG)[:, :, None]
    y_ssm = y_ssm.reshape(b, L, SSM_INNER) * jax.nn.silu(z)
    y_ssm = _rms(y_ssm.reshape(b, L, SSM_GROUPS, SSM_INNER // SSM_GROUPS)).reshape(b, L, SSM_INNER)
    p_ssm = (y_ssm * ssm_norm_w.astype(y_ssm.dtype)) @ w_proj_ssm

    pos = pos0 + jnp.arange(L)
    qh = _rope(q.reshape(b, L, RET_HEADS, RET_DK), pos)
    kh = _rope(k.reshape(b, L, RET_HEADS, RET_DK), pos) * (RET_DK ** -0.5)
    log_gamma = jnp.log1p(-jnp.exp2(-5.0 - jnp.arange(RET_HEADS, dtype=jnp.float32)))
    log_a_ret = jnp.broadcast_to(log_gamma[:, None], (b, L, RET_HEADS, 1))
    o, ret_new = chunked_decay_scan(
        qh, kh, v.reshape(b, L, RET_HEADS, 1, RET_DV), log_a_ret,
        ret_state.reshape(b, RET_HEADS, 1, RET_DV, RET_DK))
    o = _rms(o.reshape(b, L, RET_HEADS, RET_DV)).reshape(b, L, RET_V) * jax.nn.silu(g)
    p_ret = o @ w_proj_ret

    g_ssm, g_ret = _split_cols(gates, (D_MODEL, D_MODEL))
    merged = jax.nn.sigmoid(g_ssm) * p_ssm + jax.nn.sigmoid(g_ret) * p_ret
    out = merged @ w_out
    y = x + _rmsnorm(out, w_post)
    return (y, new_conv,
            ssm_new.reshape(b, SSM_HEADS, SSM_HEADDIM, SSM_STATE),
            ret_new.reshape(b, RET_HEADS, RET_DV, RET_DK))


def setup_inputs(seed: int = 0) -> dict:
    key = jax.random.key(seed)
    ks = jax.random.split(key, 17)
    f32 = jnp.float32
    nrm = lambda kk, shape, s: s * jax.random.normal(kk, shape, f32)
    x_prompt = nrm(ks[0], (BATCH, SEQ, D_MODEL), 1.0)
    x_sample = nrm(ks[1], (DEC_BATCH, DEC_SEQ, D_MODEL), 1.0)
    cache_conv = nrm(ks[2], (DEPTH, DEC_BATCH, CONV_W - 1, CONV_DIM), 1.0)
    state_ssm = nrm(ks[3], (DEPTH, DEC_BATCH, SSM_HEADS, SSM_HEADDIM, SSM_STATE), 0.3)
    state_ret = nrm(ks[4], (DEPTH, DEC_BATCH, RET_HEADS, RET_DV, RET_DK), 1.0)
    w_pre = 1.0 + nrm(ks[5], (DEPTH, D_MODEL), 0.05)
    w_in = nrm(ks[6], (DEPTH, D_MODEL, IN_DIM), D_MODEL ** -0.5)
    conv_w = nrm(ks[7], (DEPTH, CONV_W, CONV_DIM), CONV_W ** -0.5)
    conv_b = nrm(ks[8], (DEPTH, CONV_DIM), 0.02)
    dt0 = jnp.exp(jax.random.uniform(ks[9], (DEPTH, SSM_HEADS), f32, math.log(1e-3), math.log(1e-1)))
    dt_bias = dt0 + jnp.log(-jnp.expm1(-dt0))
    a_log = jnp.log(jax.random.uniform(ks[10], (DEPTH, SSM_HEADS), f32, 1.0, 16.0))
    d_skip = 1.0 + nrm(ks[11], (DEPTH, SSM_HEADS), 0.1)
    ssm_norm_w = 1.0 + nrm(ks[12], (DEPTH, SSM_INNER), 0.05)
    w_proj_ssm = nrm(ks[13], (DEPTH, SSM_INNER, D_MODEL), SSM_INNER ** -0.5)
    w_proj_ret = nrm(ks[14], (DEPTH, RET_V, D_MODEL), RET_V ** -0.5)
    w_out = nrm(ks[15], (DEPTH, D_MODEL, D_MODEL), D_MODEL ** -0.5)
    w_post = 1.0 + nrm(ks[16], (DEPTH, D_MODEL), 0.05)
    return {"x_prompt": x_prompt, "x_sample": x_sample, "cache_conv": cache_conv,
            "state_ssm": state_ssm, "state_ret": state_ret, "w_pre": w_pre, "w_in": w_in,
            "conv_w": conv_w, "conv_b": conv_b, "dt_bias": dt_bias, "a_log": a_log,
            "d_skip": d_skip, "ssm_norm_w": ssm_norm_w, "w_proj_ssm": w_proj_ssm,
            "w_proj_ret": w_proj_ret, "w_out": w_out, "w_post": w_post}


def reference(x_prompt, x_sample, cache_conv, state_ssm, state_ret, w_pre, w_in, conv_w, conv_b,
              dt_bias, a_log, d_skip, ssm_norm_w, w_proj_ssm, w_proj_ret, w_out, w_post):
    yp, ys = x_prompt, x_sample
    bp = x_prompt.shape[0]
    conv_p, ssm_p, ret_p, conv_s, ssm_s, ret_s = [], [], [], [], [], []
    for li in range(DEPTH):
        params = (w_pre[li], w_in[li], conv_w[li], conv_b[li], dt_bias[li], a_log[li], d_skip[li],
                  ssm_norm_w[li], w_proj_ssm[li], w_proj_ret[li], w_out[li], w_post[li])
        zc = jnp.zeros((bp, CONV_W - 1, CONV_DIM), yp.dtype)
        zs = jnp.zeros((bp, SSM_HEADS, SSM_HEADDIM, SSM_STATE), yp.dtype)
        zr = jnp.zeros((bp, RET_HEADS, RET_DV, RET_DK), yp.dtype)
        yp, cp, sp, rp = mixer_layer(yp, zc, zs, zr, 0, *params)
        ys, cs, ss, rs = mixer_layer(ys, cache_conv[li], state_ssm[li], state_ret[li], PAST_LEN, *params)
        conv_p.append(cp); ssm_p.append(sp); ret_p.append(rp)
        conv_s.append(cs); ssm_s.append(ss); ret_s.append(rs)
    return (yp, ys, jnp.stack(conv_p), jnp.stack(ssm_p), jnp.stack(ret_p),
            jnp.stack(conv_s), jnp.stack(ssm_s), jnp.stack(ret_s))
```

```cpp
#include <hip/hip_runtime.h>
#include <cstdio>
#include <cstdint>
namespace pg8 {
#define PG8_LAS __attribute__((address_space(3)))
typedef unsigned short bf16_t;
typedef short bf16x8 __attribute__((ext_vector_type(8)));
typedef float f32x4 __attribute__((ext_vector_type(4)));
typedef unsigned u32x4 __attribute__((ext_vector_type(4)));
constexpr int BM = 256, BK = 64, HALF = 128, HTB = HALF * BK * 2  , STAGE_BYTES = 8 * HTB, NXCD = 8, WGM = 8;

__host__ __device__ __forceinline__ int lds_byte(int r, int c) { const int st = (r >> 4) * 2 + (c >> 5), rr = r & 15, cc = c & 31, ob = rr * 64 + cc * 2; return st * 1024 + (ob ^ (((ob >> 9) & 1) << 5)); }
__host__ __device__ __forceinline__ void stage_rc(int b, int& R, int& C) { const int st = b / 1024, sb = b % 1024, swz = sb ^ (((sb >> 9) & 1) << 5); R = (st >> 1) * 16 + swz / 64; C = (st & 1) * 32 + (swz % 64) / 2; }
__host__ __device__ __forceinline__ int perm32(int rho) { const int n = rho >> 4, i = rho & 15; return 8 * (i >> 2) + 4 * n + (i & 3); }

struct Unit { int pm, pn, sel, k0, nt, mode; };
struct Gemm { const bf16_t* A; const bf16_t* Bt; int M, N, K; const bf16_t* A2; const bf16_t* Bt2; };

struct StaticOrder {
    int nM, nN, nwg, G, c, ntk;
    __host__ __device__ void init(int M, int N, int K, int G_, int c_) { nM = M / BM; nN = N / BM; nwg = nM * nN; G = G_; c = c_; ntk = K / BK; }
    __host__ __device__ bool next(int i, Unit& u) const {
        const long L = (long)i * G + c; if (L >= nwg) return false;
        int wgid = (int)L; { const int q = nwg / NXCD, r = nwg % NXCD, xcd = wgid % NXCD, off = wgid / NXCD; wgid = (xcd < r ? xcd * (q + 1) : r * (q + 1) + (xcd - r) * q) + off; }
        const int nig = WGM * nN, gid = wgid / nig, fm = gid * WGM, gsz = (nM - fm) < WGM ? (nM - fm) : WGM;
        u.pm = fm + ((wgid % nig) % gsz); u.pn = (wgid % nig) / gsz; u.sel = 0; u.k0 = 0; u.nt = ntk; u.mode = 0; return true;
    }
    __device__ __forceinline__ void a_ready(const Unit&) const {}
    __device__ __forceinline__ void done(const Unit&) const {}
};

__device__ __forceinline__ unsigned cvt_pk_bf16(float lo, float hi) { unsigned r; asm volatile("v_cvt_pk_bf16_f32 %0, %1, %2" : "=v"(r) : "v"(lo), "v"(hi)); return r; }
typedef float f32x2 __attribute__((ext_vector_type(2)));

constexpr int PROJ_NCT = 210;
__device__ __forceinline__ size_t toff(int row, int col, int nct) { return ((size_t)(row >> 7) * nct + (col >> 7)) * 16384 + (size_t)(row & 127) * 128 + (col & 127); }
__device__ __forceinline__ float bf_lo(unsigned w) { return __uint_as_float(w << 16); }
__device__ __forceinline__ float bf_hi(unsigned w) { return __uint_as_float(w & 0xffff0000u); }
__device__ __forceinline__ float sigmoidf_(float x) { return __builtin_amdgcn_rcpf(1.0f + __expf(-x)); }

struct EpiProj {
    static constexpr bool PERM = true, AFTER_DRAIN = false, HAS_MID = false;
    bf16_t* O; float* DT; int ldp; int dt_tile; const float* COS; const float* SIN; int qk_tile0, k_tile0, npr;
    __device__ __forceinline__ void operator()(const f32x4 (&acc)[2][2][4][2], const Unit& u, int wr, int wc, int fr, int fq) const {
        asm volatile("" : "+v"(fr), "+v"(fq));
        const int row0 = u.pm * BM + wr * 64 + fr; const unsigned lane_off = (unsigned)(fr * 256 + fq * 16);
        if (u.pn >= qk_tile0 && u.pn < qk_tile0 + 16) {
            const int col0 = u.pn * BM + wc * 32 + 8 * fq, ic = wc * 32 + 8 * fq; const float sc = u.pn >= k_tile0 ? 0.0625f : 1.0f;
#pragma unroll
            for (int ai = 0; ai < 2; ++ai)
#pragma unroll
                for (int m = 0; m < 4; ++m) { const int row = row0 + ai * HALF + m * 16, pidx = row < npr ? (row & 2047) : 2048 + (row & 3);
                    char* tb = (char*)O + (((size_t)(2 * u.pm + ai) * PROJ_NCT + 2 * u.pn) * 16384 + (wr * 64 + m * 16) * 128 + wc * 32) * 2 + lane_off;
                    const f32x4 c0 = *(const f32x4*)(COS + pidx * 128 + ic), c1 = *(const f32x4*)(COS + pidx * 128 + ic + 4), s0 = *(const f32x4*)(SIN + pidx * 128 + ic), s1 = *(const f32x4*)(SIN + pidx * 128 + ic + 4);
                    const f32x4 a0 = acc[ai][0][m][0], a1 = acc[ai][0][m][1], b0 = acc[ai][1][m][0], b1 = acc[ai][1][m][1];
                    const f32x4 o0 = (a0 * c0 - b0 * s0) * sc, o1 = (a1 * c1 - b1 * s1) * sc, p0 = (b0 * c0 + a0 * s0) * sc, p1 = (b1 * c1 + a1 * s1) * sc;
                    u32x4 w; w.x = cvt_pk_bf16(o0[0], o0[1]); w.y = cvt_pk_bf16(o0[2], o0[3]); w.z = cvt_pk_bf16(o1[0], o1[1]); w.w = cvt_pk_bf16(o1[2], o1[3]);
                    *(u32x4*)tb = w;
                    w.x = cvt_pk_bf16(p0[0], p0[1]); w.y = cvt_pk_bf16(p0[2], p0[3]); w.z = cvt_pk_bf16(p1[0], p1[1]); w.w = cvt_pk_bf16(p1[2], p1[3]);
                    *(u32x4*)(tb + 32768) = w;
                    asm volatile("" ::: "memory"); }
        } else if (u.pn != dt_tile) {
            const int col0 = u.pn * BM + wc * 32 + 8 * fq;
#pragma unroll
            for (int ai = 0; ai < 2; ++ai)
#pragma unroll
                for (int m = 0; m < 4; ++m) { char* tb = (char*)O + (((size_t)(2 * u.pm + ai) * PROJ_NCT + 2 * u.pn) * 16384 + (wr * 64 + m * 16) * 128 + wc * 32) * 2 + lane_off;
#pragma unroll
                    for (int bj = 0; bj < 2; ++bj) { const f32x4 v0 = acc[ai][bj][m][0], v1 = acc[ai][bj][m][1];
                        u32x4 w; w.x = cvt_pk_bf16(v0[0], v0[1]); w.y = cvt_pk_bf16(v0[2], v0[3]); w.z = cvt_pk_bf16(v1[0], v1[1]); w.w = cvt_pk_bf16(v1[2], v1[3]);
                        *(u32x4*)(tb + bj * 32768) = w; }
                    asm volatile("" ::: "memory"); }
        } else if (wc < 2) {
#pragma unroll
            for (int ai = 0; ai < 2; ++ai)
#pragma unroll
                for (int m = 0; m < 4; ++m) { float* rp = DT + (size_t)(row0 + ai * HALF + m * 16) * 64 + wc * 32 + 8 * fq;
                    *(f32x4*)rp = acc[ai][0][m][0]; *(f32x4*)(rp + 4) = acc[ai][0][m][1]; }
        }
    }
};
struct EpiDual {
    static constexpr bool PERM = true, AFTER_DRAIN = false, HAS_MID = true;
    const bf16_t* gate; int ldg; int gcol; bf16_t* MG; float* MFS; int prompt_panels;
    __device__ __forceinline__ void mid(f32x4 (&acc)[2][2][4][2], const Unit& u, int wr, int wc, int fr, int fq) const {
        asm volatile("" : "+v"(fr), "+v"(fq));
        const int row0 = u.pm * BM + wr * 64 + fr, col0 = u.pn * BM + wc * 32 + 8 * fq;
#pragma unroll
        for (int ai = 0; ai < 2; ++ai)
#pragma unroll
            for (int m = 0; m < 4; ++m) { const size_t r = (size_t)(row0 + ai * HALF + m * 16);
#pragma unroll
                for (int bj = 0; bj < 2; ++bj) { const int c = col0 + bj * HALF;
                    const bf16_t* gp = gate + ((size_t)(2 * u.pm + ai) * PROJ_NCT + ((gcol + c) >> 7)) * 16384 + (wr * 64 + m * 16 + fr) * 128 + wc * 32 + 8 * fq;
                    const u32x4 g1 = *(const u32x4*)gp, g2 = *(const u32x4*)(gp + 16 * 16384);
#define RAT_(a, b) ((1.0f + __expf(-(b))) * __builtin_amdgcn_rcpf(1.0f + __expf(-(a))))
                    f32x4& v0 = acc[ai][bj][m][0]; f32x4& v1 = acc[ai][bj][m][1];
                    v0[0] *= RAT_(bf_lo(g1.x), bf_lo(g2.x)); v0[1] *= RAT_(bf_hi(g1.x), bf_hi(g2.x)); v0[2] *= RAT_(bf_lo(g1.y), bf_lo(g2.y)); v0[3] *= RAT_(bf_hi(g1.y), bf_hi(g2.y));
                    v1[0] *= RAT_(bf_lo(g1.z), bf_lo(g2.z)); v1[1] *= RAT_(bf_hi(g1.z), bf_hi(g2.z)); v1[2] *= RAT_(bf_lo(g1.w), bf_lo(g2.w)); v1[3] *= RAT_(bf_hi(g1.w), bf_hi(g2.w));
#undef RAT_
                }
                asm volatile("" ::: "memory"); }
    }
    __device__ __forceinline__ void operator()(const f32x4 (&acc)[2][2][4][2], const Unit& u, int wr, int wc, int fr, int fq) const {
        asm volatile("" : "+v"(fr), "+v"(fq));
        const int row0 = u.pm * BM + wr * 64 + fr, col0 = u.pn * BM + wc * 32 + 8 * fq;
        const bool prompt = u.pm < prompt_panels; const int gc = gcol + ((prompt || u.sel) ? 2048 : 0);
#pragma unroll
        for (int ai = 0; ai < 2; ++ai)
#pragma unroll
            for (int m = 0; m < 4; ++m) { const size_t r = (size_t)(row0 + ai * HALF + m * 16);
#pragma unroll
                for (int bj = 0; bj < 2; ++bj) { const int c = col0 + bj * HALF;
                    const u32x4 gw = *(const u32x4*)(gate + ((size_t)(2 * u.pm + ai) * PROJ_NCT + ((gc + c) >> 7)) * 16384 + (wr * 64 + m * 16 + fr) * 128 + wc * 32 + 8 * fq);
                    const f32x4 v0 = acc[ai][bj][m][0], v1 = acc[ai][bj][m][1];
                    f32x4 o0, o1;
                    o0[0] = v0[0] * sigmoidf_(bf_lo(gw.x)); o0[1] = v0[1] * sigmoidf_(bf_hi(gw.x)); o0[2] = v0[2] * sigmoidf_(bf_lo(gw.y)); o0[3] = v0[3] * sigmoidf_(bf_hi(gw.y));
                    o1[0] = v1[0] * sigmoidf_(bf_lo(gw.z)); o1[1] = v1[1] * sigmoidf_(bf_hi(gw.z)); o1[2] = v1[2] * sigmoidf_(bf_lo(gw.w)); o1[3] = v1[3] * sigmoidf_(bf_hi(gw.w));
                    if (prompt) { u32x4 w; w.x = cvt_pk_bf16(o0[0], o0[1]); w.y = cvt_pk_bf16(o0[2], o0[3]); w.z = cvt_pk_bf16(o1[0], o1[1]); w.w = cvt_pk_bf16(o1[2], o1[3]);
                        *(u32x4*)(MG + r * 2048 + c) = w; }
                    else { float* d = MFS + ((size_t)(u.sel * 8 + (u.k0 >> 9)) * 512 + (r - (size_t)prompt_panels * BM)) * 2048 + c;
                        *(f32x4*)d = o0; *(f32x4*)(d + 4) = o1; } }
                asm volatile("" ::: "memory"); }
    }
};
struct EpiOut2 {
    static constexpr bool PERM = true, AFTER_DRAIN = false, HAS_MID = false;
    float* OF; float* OFS; int prompt_panels;
    __device__ __forceinline__ void operator()(const f32x4 (&acc)[2][2][4][2], const Unit& u, int wr, int wc, int fr, int fq) const {
        asm volatile("" : "+v"(fr), "+v"(fq));
        const int row0 = u.pm * BM + wr * 64 + fr, col0 = u.pn * BM + wc * 32 + 8 * fq; const bool prompt = u.pm < prompt_panels;
#pragma unroll
        for (int ai = 0; ai < 2; ++ai)
#pragma unroll
            for (int m = 0; m < 4; ++m) { const size_t r = (size_t)(row0 + ai * HALF + m * 16);
                float* rp = prompt ? OF + r * 2048 + col0 : OFS + ((size_t)(u.k0 >> 8) * 512 + (r - (size_t)prompt_panels * BM)) * 2048 + col0;
#pragma unroll
                for (int bj = 0; bj < 2; ++bj) { *(f32x4*)(rp + bj * HALF) = acc[ai][bj][m][0]; *(f32x4*)(rp + bj * HALF + 4) = acc[ai][bj][m][1]; } }
    }
};
struct DualOrder {
    int G, c;
    __device__ __forceinline__ bool next(int i, Unit& u) const {
        const int nd = c < 256 ? (256 - c + G - 1) / G : 0;
        if (i < 2 * nd) { const int j = c + (i >> 1) * G, vj = (j & 7) * 32 + (j >> 3); u.pm = vj >> 3; u.pn = vj & 7; u.sel = i & 1; u.k0 = 0; u.nt = 64; u.mode = (i & 1) ? 2 : 1; return true; }
        const int s = c + (i - 2 * nd) * G; if (s >= 256) return false;
        const int ks = s & 15; u.pm = 32 + (s >> 7); u.pn = (s >> 4) & 7; u.sel = ks >> 3; u.k0 = (ks & 7) * 512; u.nt = 8; u.mode = 0; return true;
    }
    __device__ __forceinline__ void a_ready(const Unit&) const {}
    __device__ __forceinline__ void done(const Unit&) const {}
};
struct OutOrder {
    int G, c;
    __device__ __forceinline__ bool next(int i, Unit& u) const {
        const int nd = c < 256 ? (256 - c + G - 1) / G : 0;
        if (i < nd) { const int j = c + i * G, vj = (j & 7) * 32 + (j >> 3); u.pm = vj >> 3; u.pn = vj & 7; u.sel = 0; u.k0 = 0; u.nt = 32; u.mode = 0; return true; }
        const int s = c + (i - nd) * G; if (s >= 128) return false;
        u.pm = 32 + (s >> 6); u.pn = (s >> 3) & 7; u.sel = 0; u.k0 = (s & 7) * 256; u.nt = 4; u.mode = 0; return true;
    }
    __device__ __forceinline__ void a_ready(const Unit&) const {}
    __device__ __forceinline__ void done(const Unit&) const {}
};
template <class Epi, class Sched, bool ALIGN_EPI = false, bool SP2 = false>
__device__ __forceinline__ void gemm_phase(PG8_LAS unsigned char* lds, const Gemm g, const Sched& S, const Epi& E) {
    const int tid = threadIdx.x, wid = __builtin_amdgcn_readfirstlane(tid >> 6), lane = tid & 63, wr = wid >> 2, wc = wid & 3, fr = lane & 15, fq = lane >> 4;
    const int K = g.K;
    unsigned voffA[2], voffB[2];
#pragma unroll
    for (int i = 0; i < 2; ++i) { int R, C; stage_rc(tid * 16 + i * 8192, R, C); const int Rb = Epi::PERM ? ((R & ~31) + perm32(R & 31)) : R;
        voffA[i] = (unsigned)(R * K + C) * 2u; voffB[i] = (unsigned)(Rb * K + C) * 2u; }
    const size_t kstep = (size_t)(BK * 2);
    const size_t hstep = (size_t)HALF * K * 2;
    const size_t tstep = 2 * hstep;
    const unsigned ldsw = (unsigned)wid * 1024u;
    const int aoff = lds_byte(wr * 64 + fr, fq * 8), boff = lds_byte(wc * 32 + fr, fq * 8);
#define PG8_SA(b, h) (((b) * 2 + (h)) * HTB)
#define PG8_SB(b, h) ((4 + (b) * 2 + (h)) * HTB)
#define PG8_STAGE(bufoff, gbase, voff) do { _Pragma("unroll") for (int _i = 0; _i < 2; ++_i) \
        __builtin_amdgcn_global_load_lds((const unsigned*)((const char*)(gbase) + (voff)[_i]), (PG8_LAS unsigned*)(lds + (bufoff) + ldsw + _i * 8192), 16, 0, 0); } while (0)
#define PG8_LDA(dst, b, h) do { _Pragma("unroll") for (int m = 0; m < 4; ++m) _Pragma("unroll") for (int k = 0; k < 2; ++k) dst[m][k] = *(const PG8_LAS bf16x8*)(lds + PG8_SA(b, h) + aoff + m * 2048 + k * 1024); } while (0)
#define PG8_LDB(dst, b, h) do { _Pragma("unroll") for (int n = 0; n < 2; ++n) _Pragma("unroll") for (int k = 0; k < 2; ++k) dst[n][k] = *(const PG8_LAS bf16x8*)(lds + PG8_SB(b, h) + boff + n * 2048 + k * 1024); } while (0)
#define PG8_MMA(ai, bj, At, Bt) do { __builtin_amdgcn_s_setprio(1); _Pragma("unroll") for (int m = 0; m < 4; ++m) _Pragma("unroll") for (int n = 0; n < 2; ++n) _Pragma("unroll") for (int k = 0; k < 2; ++k) \
        acc[ai][bj][m][n] = __builtin_amdgcn_mfma_f32_16x16x32_bf16(Bt[n][k], At[m][k], acc[ai][bj][m][n], 0, 0, 0); __builtin_amdgcn_s_setprio(0); } while (0)
#define PG8_WAIT_V(n) asm volatile("s_waitcnt vmcnt(" #n ")" ::: "memory")
#define PG8_WAIT_L(n) asm volatile("s_waitcnt lgkmcnt(" #n ")" ::: "memory")
#define PG8_BAR __builtin_amdgcn_s_barrier()
#define PG8_SCHED __builtin_amdgcn_sched_barrier(0)
    Unit cur, nxt; int ui = 0;
    if (!S.next(0, cur)) return;
    f32x4 acc[2][2][4][2];
#pragma unroll
    for (int a = 0; a < 2; ++a)
#pragma unroll
        for (int b = 0; b < 2; ++b)
#pragma unroll
            for (int m = 0; m < 4; ++m)
#pragma unroll
                for (int n = 0; n < 2; ++n) acc[a][b][m][n] = (f32x4){0.f, 0.f, 0.f, 0.f};
    bf16x8 At[4][2], B0[2][2], B1[2][2];
    const char* cA = (const char*)(cur.sel ? g.A2 : g.A) + (size_t)cur.pm * tstep + (size_t)cur.k0 * 2; const char* cB = (const char*)(cur.sel ? g.Bt2 : g.Bt) + (size_t)cur.pn * tstep + (size_t)cur.k0 * 2;
    S.a_ready(cur);
    if constexpr (SP2) {
        PG8_STAGE(PG8_SB(0, 0), cB, voffB); PG8_STAGE(PG8_SB(0, 1), cB + hstep, voffB); PG8_STAGE(PG8_SA(0, 0), cA, voffA); PG8_STAGE(PG8_SA(0, 1), cA + hstep, voffA);
        if (wr == 1) PG8_BAR;
        PG8_WAIT_V(2); PG8_BAR;
        PG8_STAGE(PG8_SB(1, 0), cB + kstep, voffB); PG8_STAGE(PG8_SA(1, 0), cA + kstep, voffA); PG8_STAGE(PG8_SB(1, 1), cB + hstep + kstep, voffB);
        PG8_WAIT_V(6); PG8_BAR;
    } else {
        PG8_STAGE(PG8_SB(0, 0), cB, voffB); PG8_STAGE(PG8_SA(0, 0), cA, voffA); PG8_STAGE(PG8_SB(0, 1), cB + hstep, voffB); PG8_STAGE(PG8_SA(0, 1), cA + hstep, voffA);
        if (wr == 1) PG8_BAR;
        PG8_WAIT_V(4); PG8_BAR;
        PG8_STAGE(PG8_SB(1, 0), cB + kstep, voffB); PG8_STAGE(PG8_SA(1, 0), cA + kstep, voffA); PG8_STAGE(PG8_SB(1, 1), cB + hstep + kstep, voffB);
        PG8_WAIT_V(6); PG8_BAR;
    }
    for (;;) {
        const bool has_next = S.next(ui + 1, nxt);
        const char* nA = has_next ? (const char*)(nxt.sel ? g.A2 : g.A) + (size_t)nxt.pm * tstep + (size_t)nxt.k0 * 2 : cA; const char* nB = has_next ? (const char*)(nxt.sel ? g.Bt2 : g.Bt) + (size_t)nxt.pn * tstep + (size_t)nxt.k0 * 2 : cB;
        const int nt = cur.nt;
        for (int t = 0; t < nt; t += 2) {
            const bool last = (t == nt - 2);
            const char* a1 = cA + (size_t)(t + 1) * kstep;
            const char* a2 = last ? nA : cA + (size_t)(t + 2) * kstep; const char* b2 = last ? nB : cB + (size_t)(t + 2) * kstep;
            const char* a3 = a2 + kstep; const char* b3 = b2 + kstep;
            if (last && has_next) S.a_ready(nxt);
            if constexpr (SP2) {
            PG8_LDB(B0, 0, 0); PG8_LDB(B1, 0, 1); PG8_SCHED; PG8_LDA(At, 0, 0); PG8_STAGE(PG8_SA(1, 1), a1 + hstep, voffA);
            PG8_WAIT_V(8); PG8_WAIT_L(0); PG8_BAR; PG8_MMA(0, 0, At, B0); PG8_MMA(0, 1, At, B1); PG8_BAR; PG8_SCHED;
            PG8_LDA(At, 0, 1); PG8_STAGE(PG8_SB(0, 0), b2, voffB); PG8_STAGE(PG8_SB(0, 1), b2 + hstep, voffB); PG8_STAGE(PG8_SA(0, 0), a2, voffA);
            PG8_WAIT_V(8); PG8_WAIT_L(0); PG8_BAR; PG8_MMA(1, 0, At, B0); PG8_MMA(1, 1, At, B1); PG8_BAR; PG8_SCHED;
            PG8_LDB(B0, 1, 0); PG8_LDB(B1, 1, 1); PG8_SCHED; PG8_LDA(At, 1, 0); PG8_STAGE(PG8_SA(0, 1), a2 + hstep, voffA);
            PG8_WAIT_V(8); PG8_WAIT_L(0); PG8_BAR; PG8_MMA(0, 0, At, B0); PG8_MMA(0, 1, At, B1); PG8_BAR; PG8_SCHED;
            PG8_LDA(At, 1, 1); PG8_STAGE(PG8_SB(1, 0), b3, voffB); PG8_STAGE(PG8_SB(1, 1), b3 + hstep, voffB); PG8_STAGE(PG8_SA(1, 0), a3, voffA);
            PG8_WAIT_V(8); PG8_WAIT_L(0); PG8_BAR; PG8_MMA(1, 0, At, B0); PG8_MMA(1, 1, At, B1); PG8_BAR; PG8_SCHED;
            } else {
            PG8_LDB(B0, 0, 0); PG8_SCHED; PG8_LDA(At, 0, 0); PG8_STAGE(PG8_SA(1, 1), a1 + hstep, voffA);
            PG8_WAIT_L(8); PG8_BAR; PG8_WAIT_L(0); PG8_MMA(0, 0, At, B0); PG8_BAR; PG8_SCHED;
            PG8_LDB(B1, 0, 1); PG8_STAGE(PG8_SB(0, 0), b2, voffB);
            PG8_BAR; PG8_WAIT_L(0); PG8_MMA(0, 1, At, B1); PG8_BAR;
            PG8_LDA(At, 0, 1); PG8_STAGE(PG8_SA(0, 0), a2, voffA);
            PG8_BAR; PG8_WAIT_L(0); PG8_MMA(1, 0, At, B0); PG8_BAR; PG8_SCHED;
            PG8_STAGE(PG8_SB(0, 1), b2 + hstep, voffB);
            PG8_WAIT_V(6); PG8_BAR; PG8_MMA(1, 1, At, B1); PG8_BAR;
            PG8_LDB(B0, 1, 0); PG8_SCHED; PG8_LDA(At, 1, 0); PG8_STAGE(PG8_SA(0, 1), a2 + hstep, voffA);
            PG8_WAIT_L(8); PG8_BAR; PG8_WAIT_L(0); PG8_MMA(0, 0, At, B0); PG8_BAR; PG8_SCHED;
            PG8_LDB(B1, 1, 1); PG8_STAGE(PG8_SB(1, 0), b3, voffB);
            PG8_BAR; PG8_WAIT_L(0); PG8_MMA(0, 1, At, B1); PG8_BAR;
            PG8_LDA(At, 1, 1); PG8_STAGE(PG8_SA(1, 0), a3, voffA);
            PG8_BAR; PG8_WAIT_L(0); PG8_MMA(1, 0, At, B0); PG8_BAR; PG8_SCHED;
            PG8_STAGE(PG8_SB(1, 1), b3 + hstep, voffB);
            PG8_WAIT_V(6); PG8_BAR; PG8_MMA(1, 1, At, B1); PG8_BAR;
            }
        }
        if constexpr (ALIGN_EPI) { if (wr == 0) PG8_BAR; }
        bool keep = false;
        if constexpr (Epi::HAS_MID) { if (cur.mode == 1) { E.mid(acc, cur, wr, wc, fr, fq); keep = true; } }
        if constexpr (!Epi::AFTER_DRAIN) { if (!keep) { E(acc, cur, wr, wc, fr, fq); S.done(cur); } }
        if (!has_next) break;
        if (!keep) {
#pragma unroll
        for (int a = 0; a < 2; ++a)
#pragma unroll
            for (int b = 0; b < 2; ++b)
#pragma unroll
                for (int m = 0; m < 4; ++m)
#pragma unroll
                    for (int n = 0; n < 2; ++n) acc[a][b][m][n] = (f32x4){0.f, 0.f, 0.f, 0.f};
        }
        cur = nxt; cA = nA; cB = nB; ++ui;
        if constexpr (ALIGN_EPI) { if (wr == 1) PG8_BAR; }
    }
    PG8_WAIT_V(0);
    if constexpr (!ALIGN_EPI) { if (wr == 0) PG8_BAR; }
    PG8_BAR;
    if constexpr (Epi::AFTER_DRAIN) { E.fused(acc, cur, wr, wc, fr, fq, lds, wid, lane); S.done(cur); }
#undef PG8_SA
#undef PG8_SB
#undef PG8_STAGE
#undef PG8_LDA
#undef PG8_LDB
#undef PG8_MMA
#undef PG8_WAIT_V
#undef PG8_WAIT_L
#undef PG8_BAR
#undef PG8_SCHED
}
}

#define GAS __attribute__((address_space(1)))
#define LAS __attribute__((address_space(3)))
typedef unsigned short bf16;
typedef unsigned v4u __attribute__((ext_vector_type(4)));
typedef unsigned v2u __attribute__((ext_vector_type(2)));
typedef float f32x4 __attribute__((ext_vector_type(4)));
typedef short bf16x8 __attribute__((ext_vector_type(8)));

constexpr int NWAVES = 8;
constexpr int DM = 2048;
constexpr int NPR = 8192, NSM = 512, MT = NPR + NSM;
constexpr int SEQ = 2048, PB = 4, SB = 128, SL = 4, PAST = 16384;
constexpr int INNER = 4096, CONVD = 6144, NH = 64, NG = 8, NST = 128;
constexpr int RH = 8, RDK = 256, RDV = 512;
constexpr int IN_DIM = 26688, LDP = 26880, NTILE_IN = LDP / 256, DT_TILE = 104;
constexpr int C_Z = 0, C_XBC = 4096, C_Q = 10240, C_K = 12288, C_V = 14336, C_G = 18432, C_GATE = 22528, C_DT = 26624;
constexpr float EPS = 1e-6f;
constexpr int NCT_P = LDP / 128, NCT_X = CONVD / 128; static_assert(NCT_P == pg8::PROJ_NCT, "PROJ tiles");

constexpr size_t MiB = 1u << 20;
constexpr size_t WS_CTL = 0, CTL_ZERO_BYTES = 1 * MiB;
constexpr size_t WS_WTIN = 1 * MiB;
constexpr size_t WS_WTPS = 106 * MiB;
constexpr size_t WS_WTPR = 122 * MiB;
constexpr size_t WS_WTO  = 138 * MiB;
constexpr size_t WS_HN   = 146 * MiB;
constexpr size_t WS_PROJ = 180 * MiB;
constexpr size_t WS_DT   = 627 * MiB;
constexpr size_t WS_DTV  = 630 * MiB;
constexpr size_t WS_LA   = 633 * MiB;
constexpr size_t WS_XBCA = 636 * MiB;
constexpr size_t WS_YS   = 738 * MiB;
constexpr size_t WS_YR   = 806 * MiB;
constexpr size_t WS_MF   = 874 * MiB;
constexpr size_t WS_MG   = 942 * MiB;
constexpr size_t WS_OF   = 976 * MiB;
constexpr size_t WS_YSP0 = 1044 * MiB, WS_YSP1 = 1180 * MiB;
constexpr size_t WS_YRP0 = 1316 * MiB, WS_YRP1 = 1452 * MiB, WS_YRP2 = 1588 * MiB, WS_YRP3 = 1724 * MiB;
constexpr size_t WS_ACS  = 1860 * MiB;
constexpr size_t WS_MFS  = 1863 * MiB;
constexpr size_t WS_OFS  = 1927 * MiB;
constexpr size_t WS_COS  = 1959 * MiB, WS_SIN = 1961 * MiB;
constexpr size_t WS_END  = 1963 * MiB;
constexpr size_t WS_STS = WS_YSP0, WS_SPS = WS_YSP0 + 64 * MiB;
constexpr size_t WS_STR = WS_YSP1, WS_SPR = WS_YRP0;
static_assert(WS_WTIN + (size_t)LDP * DM * 2 <= WS_WTPS && WS_PROJ + (size_t)MT * LDP * 2 <= WS_DT && WS_XBCA + (size_t)MT * CONVD * 2 <= WS_YS, "ws map");
constexpr int CW_TMO = 0, CW_BAR = 4096;

constexpr size_t O_YP = 0, O_YS = 16777216, O_CONVP = O_YS + 1048576, O_SSMP = O_CONVP + 73728, O_RETP = O_SSMP + 2097152,
                 O_CONVS = O_RETP + 4194304, O_SSMS = O_CONVS + 2359296, O_RETS = O_SSMS + 67108864, O_END = O_RETS + 134217728;

constexpr int RING_OFF = 0, RING_BYTES = 131072, LDSCTL_OFF = 147456, MISC_OFF = LDSCTL_OFF + 320, LDS_BYTES = 163840;

#define LDS_WAIT() asm volatile("s_waitcnt lgkmcnt(0)" ::: "memory")
#define VM_WAIT() asm volatile("s_waitcnt vmcnt(0)" ::: "memory")
__device__ __forceinline__ unsigned f2bf(float f) { unsigned u = __builtin_bit_cast(unsigned, f); return (u + 0x7fffu + ((u >> 16) & 1u)) >> 16; }
typedef __bf16 hwbf2 __attribute__((ext_vector_type(2)));
typedef float hwf2 __attribute__((ext_vector_type(2)));
__device__ __forceinline__ unsigned pk2(float lo, float hi) { const hwf2 v = {lo, hi}; return __builtin_bit_cast(unsigned, __builtin_convertvector(v, hwbf2)); }
__device__ __forceinline__ size_t toff(int row, int col, int nct) { return ((size_t)(row >> 7) * nct + (col >> 7)) * 16384 + (size_t)(row & 127) * 128 + (col & 127); }
__device__ __forceinline__ float bflo(unsigned w) { return __uint_as_float(w << 16); }
__device__ __forceinline__ float bfhi(unsigned w) { return __uint_as_float(w & 0xffff0000u); }
__device__ __forceinline__ float bf2f(bf16 b) { return __uint_as_float(((unsigned)b) << 16); }
__device__ __forceinline__ float sigm(float x) { return __builtin_amdgcn_rcpf(1.0f + __expf(-x)); }
__device__ __forceinline__ float siluf(float x) { return x * __builtin_amdgcn_rcpf(1.0f + __expf(-x)); }
__device__ __forceinline__ float wave_sum(float v) {
#pragma unroll
    for (int o = 1; o < 64; o <<= 1) v += __shfl_xor(v, o);
    return v;
}
#define XB_TMO      128
#define XB_XCNT(j)  (256  + 64 * (j))
#define XB_XSUB(j)  (1280 + 64 * (j))
#define XB_XGEN(j)  (2304 + 64 * (j))
#define XB_TOP      3328
#define XB_TOPGEN   3392
#define XCD_BAR_WORDS 3456
#define XB_SPIN_CAP (1u << 18)

__device__ __forceinline__ unsigned xb_ld(unsigned* p)              { return __hip_atomic_load(p, __ATOMIC_RELAXED, __HIP_MEMORY_SCOPE_AGENT); }
__device__ __forceinline__ unsigned xb_add(unsigned* p, unsigned v) { return __hip_atomic_fetch_add(p, v, __ATOMIC_RELAXED, __HIP_MEMORY_SCOPE_AGENT); }
__device__ __forceinline__ unsigned xb_xcc_id() { return (unsigned)__builtin_amdgcn_s_getreg((3 << 11) | 20) & 0xFu; }
#define XB_SPIN(cond, bar) do { unsigned _sp = 0; while (cond) { __builtin_amdgcn_s_sleep(1); \
    if ((++_sp & 255u) == 0u) { if (xb_ld(&(bar)[XB_TMO])) break; if (_sp > XB_SPIN_CAP) { atomicAdd(&(bar)[XB_TMO], 1u); break; } } } } while (0)

struct XcdBarrier {
    unsigned* bar; unsigned x;
    volatile LAS unsigned* st;
};

__device__ __forceinline__ XcdBarrier xcd_barrier_post(unsigned* bar, volatile LAS unsigned* st) {
    XcdBarrier b; b.bar = bar; b.x = xb_xcc_id(); b.st = st;
    if (threadIdx.x == 0) (void)xb_add(&bar[XB_XCNT(b.x)], 1u);
    return b;
}
__device__ __forceinline__ void xcd_barrier_complete(unsigned* bar, unsigned x, unsigned& nloc, unsigned& nx) {
    const unsigned G = gridDim.x * gridDim.y * gridDim.z;
    unsigned sum, cnt, mine, sp = 0u;
    for (;;) {
        sum = 0u; cnt = 0u; mine = 0u;
#pragma unroll
        for (unsigned j = 0; j < 16; ++j) { const unsigned c = xb_ld(&bar[XB_XCNT(j)]); sum += c; cnt += (c > 0u) ? 1u : 0u; mine = (j == x) ? c : mine; }
        if (sum == G) break;
        __builtin_amdgcn_s_sleep(1);
        if ((++sp & 255u) == 0u) { if (xb_ld(&bar[XB_TMO])) break; if (sp > XB_SPIN_CAP) { atomicAdd(&bar[XB_TMO], 1u); break; } }
    }
    nloc = mine > 0u ? mine : 1u; nx = cnt > 0u ? cnt : 1u;
}

__device__ __forceinline__ void xcd_barrier(const XcdBarrier& b) {
    asm volatile("s_waitcnt vmcnt(0)" ::: "memory");
    __syncthreads();
    if (threadIdx.x == 0) {
        unsigned* bar = b.bar;
        __builtin_amdgcn_s_waitcnt(0);
        unsigned nloc = b.st[0], nx = b.st[1];
        if (nloc == 0u) { xcd_barrier_complete(bar, b.x, nloc, nx); b.st[0] = nloc; b.st[1] = nx; }
        const unsigned old = xb_add(&bar[XB_XSUB(b.x)], 1u);
        const unsigned gen = old / nloc;
        if (old + 1u == (gen + 1u) * nloc) {
            __builtin_amdgcn_fence(__ATOMIC_RELEASE, "agent");
            asm volatile("s_waitcnt vmcnt(0)" ::: "memory");
            const unsigned og = xb_add(&bar[XB_TOP], 1u);
            const unsigned tg = og / nx;
            if (og + 1u == (tg + 1u) * nx) xb_add(&bar[XB_TOPGEN], 1u);
            else XB_SPIN(xb_ld(&bar[XB_TOPGEN]) == tg, bar);
            __builtin_amdgcn_fence(__ATOMIC_ACQUIRE, "agent");
            xb_add(&bar[XB_XGEN(b.x)], 1u);
            asm volatile("s_waitcnt vmcnt(0)" ::: "memory");
        } else {
            XB_SPIN(xb_ld(&bar[XB_XGEN(b.x)]) == gen, bar);
            __builtin_amdgcn_fence(__ATOMIC_ACQUIRE, "agent");
            asm volatile("s_waitcnt vmcnt(0)" ::: "memory");
        }
    }
    __syncthreads();
}

struct Args { const float* in[17]; float* out; unsigned char* ws; int ph_lo, ph_hi; };
enum { I_XP = 0, I_XS, I_CCONV, I_SSSM, I_SRET, I_WPRE, I_WIN, I_CONVW, I_CONVB, I_DTB, I_ALOG, I_DSKIP, I_SNW, I_WPS, I_WPR, I_WOUT, I_WPOST };

__device__ __forceinline__ void p0_transpose_item(const float* W, int K, int N, bf16* WT, int k0, int n0, int dst_row0, LAS float* scr, int lane) {
    float tv[64];
#pragma unroll
    for (int i = 0; i < 64; ++i) tv[i] = W[(size_t)(k0 + i) * N + n0 + lane];
#pragma unroll
    for (int i = 0; i < 64; ++i) scr[i * 65 + lane] = tv[i];
    LDS_WAIT(); asm volatile("" ::: "memory");
    const int c = lane & 7;
#pragma unroll
    for (int j = 0; j < 8; ++j) { const int n = (lane >> 3) + 8 * j; const LAS float* s = scr + (8 * c) * 65 + n;
        v4u o; o.x = pk2(s[0 * 65], s[1 * 65]); o.y = pk2(s[2 * 65], s[3 * 65]); o.z = pk2(s[4 * 65], s[5 * 65]); o.w = pk2(s[6 * 65], s[7 * 65]);
        *(GAS v4u*)(WT + (size_t)(dst_row0 + n) * K + k0 + 8 * c) = o; }
    LDS_WAIT(); asm volatile("" ::: "memory");
}
__device__ __forceinline__ const float* x_row(const Args& a, int m) { return m < NPR ? a.in[I_XP] + (size_t)m * DM : a.in[I_XS] + (size_t)(m - NPR) * DM; }

__device__ __forceinline__ void p0_prologue(const Args& a, LAS unsigned char* lds, int wave, int lane) {
    LAS float* scr = (LAS float*)(lds + RING_OFF + wave * 16896);
    const int gw = blockIdx.x * NWAVES + wave, NGW = gridDim.x * NWAVES;
    bf16* WTIN = (bf16*)(a.ws + WS_WTIN); bf16* WTPS = (bf16*)(a.ws + WS_WTPS); bf16* WTPR = (bf16*)(a.ws + WS_WTPR); bf16* WTO = (bf16*)(a.ws + WS_WTO);
    constexpr int NB_IN = IN_DIM / 64;
    constexpr int I_IN = (DM / 64) * NB_IN, I_PS = (INNER / 64) * (DM / 64), I_PR = I_PS, I_O = (DM / 64) * (DM / 64);
    constexpr int NITEMS = I_IN + I_PS + I_PR + I_O;
    for (int it = gw; it < NITEMS; it += NGW) {
        int r = it;
        if (r < I_IN) { const int kb = r / NB_IN, nb = r % NB_IN, n0 = 64 * nb; const int d0 = n0 < 10240 ? n0 : (n0 < 10304 ? n0 + 16384 : n0 - 64);
            p0_transpose_item(a.in[I_WIN], DM, IN_DIM, WTIN, 64 * kb, n0, d0, scr, lane); continue; }
        r -= I_IN;
        if (r < I_PS) { const int kb = r / (DM / 64), nb = r % (DM / 64); p0_transpose_item(a.in[I_WPS], INNER, DM, WTPS, 64 * kb, 64 * nb, 64 * nb, scr, lane); continue; }
        r -= I_PS;
        if (r < I_PR) { const int kb = r / (DM / 64), nb = r % (DM / 64); p0_transpose_item(a.in[I_WPR], INNER, DM, WTPR, 64 * kb, 64 * nb, 64 * nb, scr, lane); continue; }
        r -= I_PR;
        { const int kb = r / (DM / 64), nb = r % (DM / 64); p0_transpose_item(a.in[I_WOUT], DM, DM, WTO, 64 * kb, 64 * nb, 64 * nb, scr, lane); }
    }
    { GAS v4u* z = (GAS v4u*)(WTIN + (size_t)IN_DIM * DM); const int nz = (LDP - IN_DIM) * DM / 8;
      for (int i = blockIdx.x * 512 + threadIdx.x; i < nz; i += gridDim.x * 512) z[i] = (v4u){0u, 0u, 0u, 0u}; }
    { float* COS = (float*)(a.ws + WS_COS); float* SIN = (float*)(a.ws + WS_SIN);
      for (int i = blockIdx.x * 512 + threadIdx.x; i < 2052 * 128; i += gridDim.x * 512) { const int pi = i >> 7, f = i & 127, pos = pi < 2048 ? pi : PAST + (pi - 2048);
          const double inv = exp2(-(double)f * (13.287712379549449 / 128.0)), ang = (double)pos * inv; COS[i] = (float)cos(ang); SIN[i] = (float)sin(ang); } }
    bf16* HN = (bf16*)(a.ws + WS_HN);
    const GAS f32x4* wp = (const GAS f32x4*)a.in[I_WPRE] + lane;
    for (int m = gw; m < MT; m += NGW) {
        const GAS f32x4* xr = (const GAS f32x4*)x_row(a, m) + lane;
        f32x4 v[8]; float s = 0.f;
#pragma unroll
        for (int j = 0; j < 8; ++j) { v[j] = xr[64 * j]; s += (v[j].x * v[j].x + v[j].y * v[j].y) + (v[j].z * v[j].z + v[j].w * v[j].w); }
        const float rstd = 1.0f / sqrtf(wave_sum(s) * (1.0f / DM) + EPS);
        GAS v2u* o8 = (GAS v2u*)(HN + (size_t)m * DM) + lane;
#pragma unroll
        for (int j = 0; j < 8; ++j) { const f32x4 w = wp[64 * j]; v2u o; o.x = pk2(v[j].x * rstd * w.x, v[j].y * rstd * w.y); o.y = pk2(v[j].z * rstd * w.z, v[j].w * rstd * w.w); o8[64 * j] = o; }
    }
}

__device__ __forceinline__ void p2_prep(const Args& a, LAS unsigned char* lds) {
    const bf16* PROJ = (const bf16*)(a.ws + WS_PROJ); bf16* PROJW = (bf16*)(a.ws + WS_PROJ);
    bf16* XBCA = (bf16*)(a.ws + WS_XBCA);
    const size_t gt = (size_t)blockIdx.x * 512 + threadIdx.x, NT = (size_t)gridDim.x * 512;
    const float* cw = a.in[I_CONVW]; const float* cb = a.in[I_CONVB]; const float* cache = a.in[I_CCONV];
    for (size_t it = gt; it < (size_t)(MT / 32) * (CONVD / 8); it += NT) {
        const int cg = (int)(it % (CONVD / 8)), seg = (int)(it / (CONVD / 8)), j0 = cg * 8, m0 = seg * 32;
        float w[4][8], bs[8], x0[8], x1[8], x2[8];
#pragma unroll
        for (int e = 0; e < 8; ++e) { bs[e] = cb[j0 + e];
#pragma unroll
            for (int tap = 0; tap < 4; ++tap) w[tap][e] = cw[tap * CONVD + j0 + e]; }
#define UNPK8(dst, v) do { dst[0] = bflo(v.x); dst[1] = bfhi(v.x); dst[2] = bflo(v.y); dst[3] = bfhi(v.y); dst[4] = bflo(v.z); dst[5] = bfhi(v.z); dst[6] = bflo(v.w); dst[7] = bfhi(v.w); } while (0)
        if (m0 < NPR && (m0 % SEQ) != 0) { const v4u v0 = *(const v4u*)(PROJ + toff(m0 - 3, C_XBC + j0, NCT_P)), v1 = *(const v4u*)(PROJ + toff(m0 - 2, C_XBC + j0, NCT_P)), v2 = *(const v4u*)(PROJ + toff(m0 - 1, C_XBC + j0, NCT_P));
            UNPK8(x0, v0); UNPK8(x1, v1); UNPK8(x2, v2); }
        else {
#pragma unroll
            for (int e = 0; e < 8; ++e) { x0[e] = 0.f; x1[e] = 0.f; x2[e] = 0.f; } }
#pragma unroll 1
        for (int r0 = 0; r0 < 32; r0 += 8) { v4u vv[8];
#pragma unroll
          for (int q = 0; q < 8; ++q) vv[q] = *(const v4u*)(PROJ + toff(m0 + r0 + q, C_XBC + j0, NCT_P));
#pragma unroll
          for (int q = 0; q < 8; ++q) { const int m = m0 + r0 + q;
            if (m >= NPR && ((m - NPR) % SL) == 0) { const float* cp = cache + (size_t)((m - NPR) / SL) * 3 * CONVD + j0;
#pragma unroll
                for (int e = 0; e < 8; ++e) { x0[e] = cp[e]; x1[e] = cp[CONVD + e]; x2[e] = cp[2 * CONVD + e]; } }
            const v4u v = vv[q]; float x3[8]; UNPK8(x3, v);
            float o[8];
#pragma unroll
            for (int e = 0; e < 8; ++e) { o[e] = siluf(bs[e] + w[0][e] * x0[e] + w[1][e] * x1[e] + w[2][e] * x2[e] + w[3][e] * x3[e]); x0[e] = x1[e]; x1[e] = x2[e]; x2[e] = x3[e]; }
            v4u ov; ov.x = pk2(o[0], o[1]); ov.y = pk2(o[2], o[3]); ov.z = pk2(o[4], o[5]); ov.w = pk2(o[6], o[7]);
            *(v4u*)(XBCA + toff(m, j0, NCT_X)) = ov; } }
#undef UNPK8
    }
    for (size_t i = gt; i < (size_t)(PB + SB) * 3 * CONVD; i += NT) {
        const int j = (int)(i % CONVD), bi = (int)(i / CONVD), ii = bi % 3, b = bi / 3;
        if (b < PB) a.out[O_CONVP + ((size_t)b * 3 + ii) * CONVD + j] = bf2f(PROJ[toff(b * SEQ + SEQ - 3 + ii, C_XBC + j, NCT_P)]);
        else { const int bs = b - PB; a.out[O_CONVS + ((size_t)bs * 3 + ii) * CONVD + j] = bf2f(PROJ[toff(NPR + bs * SL + 1 + ii, C_XBC + j, NCT_P)]); }
    }
    { const float* DT = (const float*)(a.ws + WS_DT); float* DTV = (float*)(a.ws + WS_DTV); float* LA = (float*)(a.ws + WS_LA);
      for (size_t i = gt; i < (size_t)MT * NH; i += NT) { const int h = (int)(i & 63); const float x = DT[i] + a.in[I_DTB][h];
          const float sp = x > 20.f ? x : log1pf(expf(x)); DTV[i] = sp; LA[i] = -sp * expf(a.in[I_ALOG][h]); }
      float* ACS = (float*)(a.ws + WS_ACS); const int lane = threadIdx.x & 63, wv = threadIdx.x >> 6;
      const float bias = a.in[I_DTB][lane], an = -expf(a.in[I_ALOG][lane]);
      LAS float* WT = (LAS float*)(lds + 8192);
      for (int ck = blockIdx.x; ck < NPR / 128; ck += gridDim.x) { float cs[16]; float acc = 0.f;
#pragma unroll
          for (int e = 0; e < 16; ++e) cs[e] = DT[(size_t)(ck * 128 + wv * 16 + e) * NH + lane] + bias;
#pragma unroll
          for (int e = 0; e < 16; ++e) { const float sp = cs[e] > 20.f ? cs[e] : log1pf(expf(cs[e])); acc += sp * an; cs[e] = acc; }
          __syncthreads(); WT[wv * 64 + lane] = acc; __syncthreads();
          float off = 0.f;
#pragma unroll
          for (int w2 = 0; w2 < 8; ++w2) off += (w2 < wv) ? WT[w2 * 64 + lane] : 0.f;
#pragma unroll
          for (int e = 0; e < 16; ++e) ACS[(size_t)(ck * 128 + wv * 16 + e) * NH + lane] = off + cs[e]; } }
}

__device__ __forceinline__ void p8_final(const Args& a, int wave, int lane) {
    const float* OF = (const float*)(a.ws + WS_OF);
    const int gw = blockIdx.x * NWAVES + wave, NGW = gridDim.x * NWAVES;
    const GAS f32x4* wp = (const GAS f32x4*)a.in[I_WPOST] + lane;
    for (int m = gw; m < MT; m += NGW) {
        const GAS f32x4* orow = (const GAS f32x4*)(OF + (size_t)m * DM) + lane; const GAS f32x4* xr = (const GAS f32x4*)x_row(a, m) + lane;
        f32x4 v[8]; float s = 0.f;
#pragma unroll
        for (int j = 0; j < 8; ++j) {
            if (m < NPR) v[j] = orow[64 * j];
            else { const GAS f32x4* ps = (const GAS f32x4*)((const float*)(a.ws + WS_OFS) + (size_t)(m - NPR) * DM) + lane + 64 * j; v[j] = ps[0];
#pragma unroll
                for (int ks = 1; ks < 8; ++ks) v[j] += ps[(size_t)ks * (NSM * DM / 4)]; }
            s += (v[j].x * v[j].x + v[j].y * v[j].y) + (v[j].z * v[j].z + v[j].w * v[j].w); }
        const float rstd = 1.0f / sqrtf(wave_sum(s) * (1.0f / DM) + EPS);
        GAS f32x4* yo = (GAS f32x4*)(a.out + (size_t)m * DM) + lane;
#pragma unroll
        for (int j = 0; j < 8; ++j) { const f32x4 w = wp[64 * j], x = xr[64 * j]; yo[64 * j] = x + v[j] * rstd * w; }
    }
}

__device__ __forceinline__ void p7_merge_sample(const Args& a) {
    const f32x4* src = (const f32x4*)(a.ws + WS_MFS); v4u* dst = (v4u*)((bf16*)(a.ws + WS_MG) + (size_t)NPR * DM);
    for (size_t i = (size_t)blockIdx.x * 512 + threadIdx.x; i < (size_t)NSM * DM / 8; i += (size_t)gridDim.x * 512) { f32x4 x0 = src[2 * i], x1 = src[2 * i + 1];
#pragma unroll
        for (int ks = 1; ks < 16; ++ks) { x0 += src[(size_t)ks * (NSM * DM / 4) + 2 * i]; x1 += src[(size_t)ks * (NSM * DM / 4) + 2 * i + 1]; }
        v4u o; o.x = pk2(x0.x, x0.y); o.y = pk2(x0.z, x0.w); o.z = pk2(x1.x, x1.y); o.w = pk2(x1.z, x1.w); dst[i] = o; }
}

typedef short s4v __attribute__((ext_vector_type(4)));
constexpr int TAB0 = LDSCTL_OFF + 1024, TAB1 = TAB0 + 4096;
static_assert(TAB1 + 4096 <= LDS_BYTES, "LDS tables");
__device__ __forceinline__ unsigned img_off(unsigned row, unsigned ch) { return 256u * row + 16u * (ch ^ (((row & 3u) << 2) | ((row >> 2) & 3u))); }
__device__ __forceinline__ s4v tr_rd(LAS unsigned char* p) { return __builtin_amdgcn_ds_read_tr16_b64_v4i16((LAS s4v*)p); }
__device__ __forceinline__ bf16x8 mk8(s4v a, s4v b) { return (bf16x8){a[0], a[1], a[2], a[3], b[0], b[1], b[2], b[3]}; }
__device__ __forceinline__ float ret_lg2(int hh) { return log2f(1.0f - exp2f(-5.0f - (float)hh)); }
#define MFMA16(a, b, c) __builtin_amdgcn_mfma_f32_16x16x32_bf16((a), (b), (c), 0, 0, 0)

__device__ __forceinline__ unsigned img64_off(unsigned row, unsigned ch) { return 128u * row + 16u * (ch ^ (((row >> 1) & 3u) << 1)); }
__device__ __forceinline__ void dma16(const void* g, LAS unsigned char* l) {
    const unsigned lds_dst = __builtin_amdgcn_readfirstlane((unsigned)(size_t)l); unsigned keep;
    asm volatile("s_mov_b32 %0, m0\n\ts_mov_b32 m0, %2\n\ts_nop 0\n\tglobal_load_lds_dwordx4 %1, off\n\ts_mov_b32 m0, %0" : "=&s"(keep) : "v"(g), "s"(lds_dst) : "memory");
}
template <int NROWS> __device__ __forceinline__ void stage256(const bf16* src, size_t ld, LAS unsigned char* dst, int wave, int lane) {
#pragma unroll
    for (int i0 = 0; i0 < NROWS / 4; i0 += 8) { const int i = i0 + wave, row = 4 * i + (lane >> 4), cs = lane & 15, ch = cs ^ (((row & 3) << 2) | ((row >> 2) & 3));
        dma16(src + (size_t)row * ld + ch * 8, dst + i * 1024); }
}
template <int NROWS> __device__ __forceinline__ void stage128(const bf16* src, size_t ld, LAS unsigned char* dst, int wave, int lane) {
#pragma unroll
    for (int i0 = 0; i0 < NROWS / 8; i0 += 8) { const int i = i0 + wave, row = 8 * i + (lane >> 3), cs = lane & 7, ch = cs ^ (((row >> 1) & 3) << 1);
        dma16(src + (size_t)row * ld + ch * 8, dst + i * 1024); }
}
struct PCtx { unsigned char* ws; const float* dskip; const float* snw; };
template <bool RET> __device__ __forceinline__ void passC_unit(const PCtx a, LAS unsigned char* lds, int b, int c, int gi, int tid, int wave, int lane) {
    constexpr int N = RET ? 256 : 128, NKI = N / 128, NKS = N / 32;
    constexpr int BUFSZ = 49152, K_OFF = RET ? 49152 : 114688, S_OFF = RET ? 16384 : 32768, Z_OFF = 16384;
    const size_t R0 = (size_t)b * SEQ + (size_t)c * 128;
    const bf16* PROJ = (const bf16*)(a.ws + WS_PROJ); const bf16* XBCA = (const bf16*)(a.ws + WS_XBCA);
    const float* DTV = (const float*)(a.ws + WS_DTV); const float* ACS = (const float*)(a.ws + WS_ACS);
    constexpr size_t ld = 128;
    const bf16* Ksrc = RET ? PROJ + toff((int)R0, C_K + gi * 256, NCT_P) : XBCA + toff((int)R0, INNER + gi * 128, NCT_X);
    const bf16* Qsrc = RET ? PROJ + toff((int)R0, C_Q + gi * 256, NCT_P) : XBCA + toff((int)R0, INNER + NG * NST + gi * 128, NCT_X);
    const bf16* Xsrc = RET ? PROJ + toff((int)R0, C_V + gi * 512, NCT_P) : XBCA + toff((int)R0, gi * 512, NCT_X);
    const bf16* Zsrc = PROJ + toff((int)R0, C_Z + gi * 512, NCT_P);
    const bf16* SP = (const bf16*)(a.ws + (RET ? WS_SPR : WS_SPS)) + (size_t)((b * 16 + c) * 8 + gi) * 8 * 64 * N;
    bf16* Yout = (bf16*)(a.ws + (RET ? WS_YR : WS_YS)) + R0 * INNER + gi * 512;
    LAS float* TA = (LAS float*)(lds + TAB0); LAS float* TD = (LAS float*)(lds + TAB1);
    const int g4 = lane >> 4, l15 = lane & 15, q4 = l15 >> 2, p4 = lane & 3, L0 = 16 * wave, lrow = L0 + l15;
    const int ps = (p4 == 1) ? 2 : (p4 == 2 ? 1 : p4), gs = (g4 == 1) ? 2 : (g4 == 2 ? 1 : g4), l15s = 4 * ((q4 == 1) ? 2 : (q4 == 2 ? 1 : q4)) + (l15 & 3);
    const bool up = lane >= 32; const int nst = up ? ((g4 == 3) ? 8 : 0) : 4 * gs;
    const float lg2 = RET ? ret_lg2(gi) : 0.f;
#define STAGE_R(r_) do { LAS unsigned char* bb_ = lds + ((r_) % 3) * BUFSZ; \
        stage128<128>(Xsrc + ((r_) >> 1) * 16384 + ((r_) & 1) * 64, ld, bb_, wave, lane); \
        if (!RET) stage128<128>(Zsrc + ((r_) >> 1) * 16384 + ((r_) & 1) * 64, ld, bb_ + Z_OFF, wave, lane); \
        _Pragma("unroll") for (int h_ = 0; h_ < NKI; ++h_) stage256<64>(SP + (size_t)(r_) * 64 * N + h_ * 128, (size_t)N, bb_ + S_OFF + h_ * 16384, wave, lane); } while (0)
    __syncthreads();
#pragma unroll
    for (int h = 0; h < NKI; ++h) stage256<128>(Ksrc + h * 16384, ld, lds + K_OFF + h * 32768, wave, lane);
    STAGE_R(0);
    if (!RET) STAGE_R(1);
    if (!RET) for (int i = tid; i < 1024; i += 512) { const int r = i >> 7, s = i & 127; TA[i] = ACS[(R0 + s) * NH + gi * 8 + r]; TD[i] = DTV[(R0 + s) * NH + gi * 8 + r]; }
    bf16x8 qf[NKS];
#pragma unroll
    for (int ks = 0; ks < NKS; ++ks) qf[ks] = *(const bf16x8*)(Qsrc + (ks >> 2) * 16384 + (size_t)lrow * ld + 32 * (ks & 3) + 8 * g4);
    asm volatile("s_waitcnt vmcnt(0)" ::: "memory");
    __syncthreads();
    f32x4 gt[8];
#pragma unroll
    for (int si = 0; si < 8; ++si) { gt[si] = (f32x4){0.f, 0.f, 0.f, 0.f};
        if (si <= wave) {
#pragma unroll
            for (int ks = 0; ks < NKS; ++ks) { const bf16x8 ka = *(const LAS bf16x8*)(lds + K_OFF + (ks >> 2) * 32768 + img_off(16 * si + l15, 4 * (ks & 3) + g4)); gt[si] = MFMA16(ka, qf[ks], gt[si]); }
            asm volatile("" ::: "memory"); } }
    bf16x8 mt[4];
    if (RET) {
#pragma unroll
        for (int kp = 0; kp < 4; ++kp) { float v[8];
#pragma unroll
            for (int t = 0; t < 2; ++t)
#pragma unroll
                for (int i = 0; i < 4; ++i) { const int s = 32 * kp + 16 * t + 4 * g4 + i; v[4 * t + i] = (s <= lrow) ? gt[2 * kp + t][i] * exp2f(lg2 * (float)(lrow - s)) : 0.f; }
            const unsigned w0 = pk2(v[0], v[1]), w1 = pk2(v[2], v[3]), w2 = pk2(v[4], v[5]), w3 = pk2(v[6], v[7]);
            mt[kp] = __builtin_bit_cast(bf16x8, (v4u){w0, w1, w2, w3}); }
    }
    float ssq = 0.f;
    __syncthreads();
    if (RET) STAGE_R(1);
#pragma unroll 1
    for (int r = 0; r < 8; ++r) {
        if (r < 6) STAGE_R(r + 2);
        LAS unsigned char* bb = lds + (r % 3) * BUFSZ;
        float el;
        if (RET) el = exp2f(lg2 * (float)(lrow + 1));
        else { const float al = TA[r * 128 + lrow]; el = __expf(al);
#pragma unroll
            for (int kp = 0; kp < 4; ++kp) if (2 * kp <= wave) { float v[8];
#pragma unroll
                for (int t = 0; t < 2; ++t) { const int s0 = 32 * kp + 16 * t + 4 * g4; const f32x4 as = *(const LAS f32x4*)(TA + r * 128 + s0), ds = *(const LAS f32x4*)(TD + r * 128 + s0);
#pragma unroll
                    for (int i = 0; i < 4; ++i) v[4 * t + i] = (s0 + i <= lrow) ? gt[2 * kp + t][i] * __expf(al - as[i]) * ds[i] : 0.f; }
                const unsigned w0 = pk2(v[0], v[1]), w1 = pk2(v[2], v[3]), w2 = pk2(v[4], v[5]), w3 = pk2(v[6], v[7]);
                mt[kp] = __builtin_bit_cast(bf16x8, (v4u){w0, w1, w2, w3}); } }
        const float Dh = RET ? 0.f : a.dskip[gi * 8 + r];
        v2u yp[2];
#pragma unroll 1
        for (int pp2 = 0; pp2 < 2; ++pp2)
#pragma unroll
        for (int ph = 0; ph < 2; ++ph) { const int pt = 2 * pp2 + ph;
            f32x4 ai = (f32x4){0.f, 0.f, 0.f, 0.f}, ae = (f32x4){0.f, 0.f, 0.f, 0.f};
            LAS unsigned char* xb = bb + 8 * (ps & 1);
#pragma unroll
            for (int kp = 0; kp < 4; ++kp) if (2 * kp <= wave) {
                const s4v lo = tr_rd(xb + img64_off(32 * kp + 4 * g4 + q4, 2 * pt + (ps >> 1))), hi = tr_rd(xb + img64_off(32 * kp + 16 + 4 * g4 + q4, 2 * pt + (ps >> 1)));
                ai = MFMA16(mk8(lo, hi), mt[kp], ai); }
#pragma unroll
            for (int ks = 0; ks < NKS; ++ks) { const bf16x8 sa = *(const LAS bf16x8*)(bb + S_OFF + (ks >> 2) * 16384 + img_off(16 * pt + l15s, 4 * (ks & 3) + g4)); ae = MFMA16(sa, qf[ks], ae); }
            float y[4];
#pragma unroll
            for (int i = 0; i < 4; ++i) y[i] = ai[i] + el * ae[i];
            if (!RET) {
                const unsigned xo = img64_off(lrow, 2 * pt + (gs >> 1)) + 8 * (gs & 1);
                const v2u xw = *(const LAS v2u*)(bb + xo), zw = *(const LAS v2u*)(bb + Z_OFF + xo);
                y[0] = (y[0] + Dh * bflo(xw.x)) * siluf(bflo(zw.x)); y[1] = (y[1] + Dh * bfhi(xw.x)) * siluf(bfhi(zw.x));
                y[2] = (y[2] + Dh * bflo(xw.y)) * siluf(bflo(zw.y)); y[3] = (y[3] + Dh * bfhi(xw.y)) * siluf(bfhi(zw.y));
            }
            ssq += (y[0] * y[0] + y[1] * y[1]) + (y[2] * y[2] + y[3] * y[3]);
            yp[ph].x = pk2(y[0], y[1]); yp[ph].y = pk2(y[2], y[3]);
            if (ph) {
                const unsigned sx = up ? yp[0].x : yp[1].x, sy = up ? yp[0].y : yp[1].y; const unsigned rx = (unsigned)__shfl_xor((int)sx, 32), ry = (unsigned)__shfl_xor((int)sy, 32);
                const v4u w = up ? (v4u){rx, ry, yp[1].x, yp[1].y} : (v4u){yp[0].x, yp[0].y, rx, ry};
                *(v4u*)(Yout + (size_t)lrow * INNER + r * 64 + 16 * (pt - 1 + (up ? 1 : 0)) + nst) = w; }
        }
        if (r < 6) asm volatile("s_waitcnt vmcnt(8)" ::: "memory"); else asm volatile("s_waitcnt vmcnt(0)" ::: "memory");
        __builtin_amdgcn_s_barrier();
        asm volatile("" ::: "memory");
    }
#undef STAGE_R
    ssq += __shfl_xor(ssq, 16); ssq += __shfl_xor(ssq, 32);
    const float rstd = 1.0f / sqrtf(ssq * (1.0f / 512.0f) + EPS);
#pragma unroll 1
    for (int hb = 0; hb < 2; ++hb) {
        v4u yw[8], gw[8];
#pragma unroll
        for (int j = 0; j < 8; ++j) { const int col = (hb * 4 + (j >> 1)) * 64 + 16 * (2 * (j & 1) + (up ? 1 : 0)) + nst;
            yw[j] = *(const v4u*)(Yout + (size_t)lrow * INNER + col);
            if (RET) gw[j] = *(const v4u*)(PROJ + toff((int)R0 + lrow, C_G + gi * 512 + col, NCT_P)); }
#pragma unroll
        for (int j = 0; j < 8; ++j) { const int col = (hb * 4 + (j >> 1)) * 64 + 16 * (2 * (j & 1) + (up ? 1 : 0)) + nst;
            float o[8] = {bflo(yw[j].x) * rstd, bfhi(yw[j].x) * rstd, bflo(yw[j].y) * rstd, bfhi(yw[j].y) * rstd, bflo(yw[j].z) * rstd, bfhi(yw[j].z) * rstd, bflo(yw[j].w) * rstd, bfhi(yw[j].w) * rstd};
            if (RET) { o[0] *= siluf(bflo(gw[j].x)); o[1] *= siluf(bfhi(gw[j].x)); o[2] *= siluf(bflo(gw[j].y)); o[3] *= siluf(bfhi(gw[j].y)); o[4] *= siluf(bflo(gw[j].z)); o[5] *= siluf(bfhi(gw[j].z)); o[6] *= siluf(bflo(gw[j].w)); o[7] *= siluf(bfhi(gw[j].w)); }
            else { const f32x4 n0 = *(const f32x4*)(a.snw + gi * 512 + col), n1 = *(const f32x4*)(a.snw + gi * 512 + col + 4); o[0] *= n0.x; o[1] *= n0.y; o[2] *= n0.z; o[3] *= n0.w; o[4] *= n1.x; o[5] *= n1.y; o[6] *= n1.z; o[7] *= n1.w; }
            v4u ov; ov.x = pk2(o[0], o[1]); ov.y = pk2(o[2], o[3]); ov.z = pk2(o[4], o[5]); ov.w = pk2(o[6], o[7]); *(v4u*)(Yout + (size_t)lrow * INNER + col) = ov; }
    }
}

__device__ __forceinline__ void passC(unsigned char* ws, const float* dskip, const float* snw, LAS unsigned char* lds) {
    const PCtx a{ws, dskip, snw}; const int tid = threadIdx.x, lane = tid & 63, wave = __builtin_amdgcn_readfirstlane(tid >> 6);
#if !defined(ONLY_SSD)
    for (int u = blockIdx.x; u < 512; u += gridDim.x) passC_unit<true>(a, lds, u >> 7, (u >> 3) & 15, u & 7, tid, wave, lane);
#endif
#if !defined(ONLY_RET)
    for (int u = blockIdx.x; u < 512; u += gridDim.x) passC_unit<false>(a, lds, u >> 7, (u >> 3) & 15, u & 7, tid, wave, lane);
#endif
}

template <bool RET> __device__ __forceinline__ void scan_unit(const Args& a, LAS unsigned char* lds, int b, int gi, int rp, int nh, int tid, int wave, int lane) {
    constexpr int N = RET ? 256 : 128;
    const bf16* PROJ = (const bf16*)(a.ws + WS_PROJ); const bf16* XBCA = (const bf16*)(a.ws + WS_XBCA);
    const float* DTV = (const float*)(a.ws + WS_DTV); const float* ACS = (const float*)(a.ws + WS_ACS);
    constexpr size_t ld = 128, CSTEP = (size_t)(RET ? NCT_P : NCT_X) * 16384;
    const size_t Rb = (size_t)b * SEQ;
    const bf16* Ksrc = RET ? PROJ + toff((int)Rb, C_K + gi * 256 + nh * 128, NCT_P) : XBCA + toff((int)Rb, INNER + gi * 128, NCT_X);
    const bf16* Xsrc = RET ? PROJ + toff((int)Rb, C_V + gi * 512 + rp * 128, NCT_P) : XBCA + toff((int)Rb, gi * 512 + rp * 128, NCT_X);
    bf16* SP = (bf16*)(a.ws + (RET ? WS_SPR : WS_SPS));
    LAS float* TBL = (LAS float*)(lds + 131072);
    const int g4 = lane >> 4, l15 = lane & 15, q4 = l15 >> 2, p4 = lane & 3;
    const int ps = (p4 == 1) ? 2 : (p4 == 2 ? 1 : p4), gs = (g4 == 1) ? 2 : (g4 == 2 ? 1 : g4);
    const bool up = lane >= 32; const int nst = up ? ((g4 == 3) ? 8 : 0) : 4 * gs;
    const float lg2 = RET ? ret_lg2(gi) : 0.f;
    float wb[4], wj[8]; const float decR = RET ? exp2f(lg2 * 128.f) : 0.f;
#pragma unroll
    for (int ks = 0; ks < 4; ++ks) wb[ks] = RET ? exp2f(lg2 * (float)(127 - (32 * ks + 8 * g4))) : 0.f;
#pragma unroll
    for (int j = 0; j < 8; ++j) wj[j] = RET ? exp2f(-lg2 * (float)j) : 0.f;
#define SC_STAGE_K(c_) stage256<128>(Ksrc + (size_t)(c_) * CSTEP, ld, lds + ((2 * (c_)) & 3) * 32768, wave, lane)
#define SC_STAGE_X(c_) stage256<128>(Xsrc + (size_t)(c_) * CSTEP, ld, lds + ((2 * (c_) + 1) & 3) * 32768, wave, lane)
#define SC_TBLVAL(c_, dst) do { if (!RET && tid < 258) { const int rr_ = tid < 256 ? (tid >> 7) : (tid - 256), s_ = tid < 256 ? (tid & 127) : 127; const int h_ = gi * 8 + 2 * rp + rr_; \
            const size_t r0_ = Rb + (size_t)(c_) * 128; const float aend_ = ACS[(r0_ + 127) * NH + h_]; \
            dst = tid < 256 ? DTV[(r0_ + s_) * NH + h_] * __expf(aend_ - ACS[(r0_ + s_) * NH + h_]) : __expf(aend_); } } while (0)
    f32x4 acc[2][4];
#pragma unroll
    for (int rr = 0; rr < 2; ++rr)
#pragma unroll
        for (int pt = 0; pt < 4; ++pt) acc[rr][pt] = (f32x4){0.f, 0.f, 0.f, 0.f};
    __syncthreads();
    SC_STAGE_K(0); SC_STAGE_X(0); SC_STAGE_K(1);
    { float tv = 0.f; SC_TBLVAL(0, tv); if (!RET && tid < 258) TBL[tid] = tv; }
    asm volatile("s_waitcnt vmcnt(0)" ::: "memory");
    __syncthreads();
#pragma unroll 1
    for (int c = 0; c < 16; ++c) {
        if (c < 15) SC_STAGE_X(c + 1);
        bf16x8 kf[4];
        { LAS unsigned char* kb = lds + ((2 * c) & 3) * 32768 + 8 * (ps & 1);
#pragma unroll
          for (int ks = 0; ks < 4; ++ks) { const s4v lo = tr_rd(kb + img_off(32 * ks + 8 * g4 + q4, 2 * wave + (ps >> 1))), hi = tr_rd(kb + img_off(32 * ks + 8 * g4 + 4 + q4, 2 * wave + (ps >> 1)));
            kf[ks] = mk8(lo, hi); } }
        asm volatile("s_waitcnt lgkmcnt(0)" ::: "memory");
        if (c < 15) asm volatile("s_waitcnt vmcnt(12)" ::: "memory"); else asm volatile("s_waitcnt vmcnt(0)" ::: "memory");
        __builtin_amdgcn_s_barrier(); asm volatile("" ::: "memory");
        float tvn = 0.f; if (c < 15) SC_TBLVAL(c + 1, tvn);
        { bf16* sp = SP + ((size_t)((b * 16 + c) * 8 + gi) * 8 + 2 * rp) * 64 * N + (RET ? nh * 128 : 0) + 16 * wave + nst;
#pragma unroll
          for (int rr = 0; rr < 2; ++rr)
#pragma unroll
            for (int pp = 0; pp < 2; ++pp) {
                v2u oe, oo; oe.x = pk2(acc[rr][2 * pp][0], acc[rr][2 * pp][1]); oe.y = pk2(acc[rr][2 * pp][2], acc[rr][2 * pp][3]);
                oo.x = pk2(acc[rr][2 * pp + 1][0], acc[rr][2 * pp + 1][1]); oo.y = pk2(acc[rr][2 * pp + 1][2], acc[rr][2 * pp + 1][3]);
                const unsigned sx = up ? oe.x : oo.x, sy = up ? oe.y : oo.y; const unsigned rx = (unsigned)__shfl_xor((int)sx, 32), ry = (unsigned)__shfl_xor((int)sy, 32);
                const v4u w = up ? (v4u){rx, ry, oo.x, oo.y} : (v4u){oe.x, oe.y, rx, ry};
                *(v4u*)(sp + (size_t)(rr * 64 + 16 * (2 * pp + (up ? 1 : 0)) + l15) * N) = w; } }
        if (c < 14) SC_STAGE_K(c + 2);
        LAS unsigned char* xb0 = lds + ((2 * c + 1) & 3) * 32768; LAS float* T = TBL + (c & 1) * 512;
#pragma unroll
        for (int rr = 0; rr < 2; ++rr) {
            const float dec = RET ? decR : T[256 + rr];
            bf16x8 kw[4];
#pragma unroll
            for (int ks = 0; ks < 4; ++ks) { float w[8];
                if (RET) {
#pragma unroll
                    for (int j = 0; j < 8; ++j) w[j] = wb[ks] * wj[j];
                } else { const f32x4 w0 = *(const LAS f32x4*)(T + rr * 128 + 32 * ks + 8 * g4), w1 = *(const LAS f32x4*)(T + rr * 128 + 32 * ks + 8 * g4 + 4);
                    w[0] = w0.x; w[1] = w0.y; w[2] = w0.z; w[3] = w0.w; w[4] = w1.x; w[5] = w1.y; w[6] = w1.z; w[7] = w1.w; }
                const v4u kv = __builtin_bit_cast(v4u, kf[ks]);
                kw[ks] = __builtin_bit_cast(bf16x8, (v4u){pk2(bflo(kv.x) * w[0], bfhi(kv.x) * w[1]), pk2(bflo(kv.y) * w[2], bfhi(kv.y) * w[3]), pk2(bflo(kv.z) * w[4], bfhi(kv.z) * w[5]), pk2(bflo(kv.w) * w[6], bfhi(kv.w) * w[7])}); }
#pragma unroll
            for (int pt = 0; pt < 4; ++pt) {
                f32x4 d = acc[rr][pt] * dec;
                LAS unsigned char* base = xb0 + 8 * (p4 & 1); const int cc = rr * 4 + pt;
#pragma unroll
                for (int ks = 0; ks < 4; ++ks) {
                    const s4v lo = tr_rd(base + img_off(32 * ks + 8 * g4 + q4, 2 * cc + (p4 >> 1))), hi = tr_rd(base + img_off(32 * ks + 8 * g4 + 4 + q4, 2 * cc + (p4 >> 1)));
                    d = MFMA16(kw[ks], mk8(lo, hi), d); }
                acc[rr][pt] = d; if (pt & 1) asm volatile("" ::: "memory"); }
        }
        if (!RET && c < 15 && tid < 258) TBL[((c + 1) & 1) * 512 + tid] = tvn;
        if (c < 14) asm volatile("s_waitcnt vmcnt(12)" ::: "memory"); else asm volatile("s_waitcnt vmcnt(0)" ::: "memory");
        asm volatile("s_waitcnt lgkmcnt(0)" ::: "memory");
        __builtin_amdgcn_s_barrier(); asm volatile("" ::: "memory");
    }
#undef SC_STAGE_K
#undef SC_STAGE_X
#undef SC_TBLVAL
    float* so = a.out + (RET ? O_RETP + ((size_t)(b * RH + gi) * RDV + rp * 128) * RDK + nh * 128 : O_SSMP + ((size_t)(b * NH + gi * 8 + 2 * rp) * 64) * NST) + 16 * wave + 4 * gs;
#pragma unroll
    for (int rr = 0; rr < 2; ++rr)
#pragma unroll
        for (int pt = 0; pt < 4; ++pt) *(f32x4*)(so + (size_t)(rr * 64 + 16 * pt + l15) * N) = acc[rr][pt];
}
__device__ __forceinline__ void scan_phase(const Args& a, LAS unsigned char* lds, int tid, int wave, int lane) {
    const int G = gridDim.x, vcu = (G % 8 == 0) ? (int)(blockIdx.x % 8) * (G / 8) + (int)(blockIdx.x / 8) : (int)blockIdx.x;
    for (int u = vcu; u < 256; u += G) scan_unit<true>(a, lds, u >> 6, (u >> 3) & 7, (u >> 1) & 3, u & 1, tid, wave, lane);
    for (int u = (vcu + 128) % G; u < 128; u += G) scan_unit<false>(a, lds, u >> 5, (u >> 2) & 7, u & 3, 0, tid, wave, lane);
}

template <bool RET> __device__ __forceinline__ void samp_stream(const Args& a, LAS unsigned char* lds, int tid, int wave, int lane) {
    constexpr int N = RET ? 256 : 128, NKS = N / 32, NSUB = N / 128, NTC = 2;
    constexpr int TSET = 28672;
    const bf16* PROJ = (const bf16*)(a.ws + WS_PROJ); const bf16* XBCA = (const bf16*)(a.ws + WS_XBCA);
    const float* DTV = (const float*)(a.ws + WS_DTV); const float* LA = (const float*)(a.ws + WS_LA);
    const bf16* Kb_ = RET ? PROJ : XBCA; const int nct = RET ? NCT_P : NCT_X;
    LAS float* SQ = (LAS float*)(lds + 2 * TSET); LAS float* YL = (LAS float*)(lds + 2 * TSET + 1024);
    const int g4 = lane >> 4, l15 = lane & 15, tt = l15 & 3;
    const int G = gridDim.x, nu = ((int)blockIdx.x < SB * 8) ? (SB * 8 - 1 - (int)blockIdx.x) / G + 1 : 0;
    f32x4 cur[8], nxt[8];
    v4u tr[NTC]; float wv = 0.f;
#define TLOAD(bs_, gi_) do { const int Rs_ = NPR + (bs_) * SL; \
        _Pragma("unroll") for (int q_ = 0; q_ < NTC; ++q_) { const int k_ = tid + 512 * q_; int t_, col_; const bf16* src_ = Kb_; int nc_ = nct; \
            if (RET) { if (k_ < 128) { t_ = k_ >> 5; col_ = C_K + (gi_) * 256 + (k_ & 31) * 8; } else if (k_ < 256) { t_ = (k_ - 128) >> 5; col_ = C_Q + (gi_) * 256 + (k_ & 31) * 8; } else if (k_ < 512) { t_ = (k_ - 256) >> 6; col_ = C_V + (gi_) * 512 + (k_ & 63) * 8; } else { const int kk_ = k_ < 768 ? k_ - 512 : 0; t_ = kk_ >> 6; col_ = C_G + (gi_) * 512 + (kk_ & 63) * 8; } } \
            else { if (k_ < 64) { t_ = k_ >> 4; col_ = INNER + (gi_) * 128 + (k_ & 15) * 8; } else if (k_ < 128) { t_ = (k_ - 64) >> 4; col_ = INNER + NG * NST + (gi_) * 128 + (k_ & 15) * 8; } \
                   else if (k_ < 384) { t_ = (k_ - 128) >> 6; col_ = (gi_) * 512 + ((k_ - 128) & 63) * 8; } else { const int kk_ = k_ < 640 ? k_ - 384 : 0; t_ = kk_ >> 6; col_ = C_Z + (gi_) * 512 + (kk_ & 63) * 8; src_ = PROJ; nc_ = NCT_P; } } \
            tr[q_] = *(const v4u*)(src_ + toff(Rs_ + t_, col_, nc_)); } \
        if (lane < 8) { if (RET) wv = lane < 4 ? (float)(lane + 1) * logf(1.0f - exp2f(-5.0f - (float)(gi_))) : 1.0f; \
            else { const int h_ = (gi_) * 8 + wave; if (lane < 4) { wv = 0.f; for (int t2 = 0; t2 <= lane; ++t2) wv += LA[(size_t)(Rs_ + t2) * NH + h_]; } else wv = DTV[(size_t)(Rs_ + lane - 4) * NH + h_]; } } } while (0)
#define TWRITE(ts_) do { LAS unsigned char* tb_ = lds + (ts_) * TSET; \
        _Pragma("unroll") for (int q_ = 0; q_ < NTC; ++q_) { const int k_ = tid + 512 * q_; int off_ = -1; \
            if (RET) { if (k_ < 128) off_ = k_ * 32; else if (k_ < 256) off_ = 4096 + (k_ - 128) * 32; else if (k_ < 512) off_ = 8192 + (k_ - 256) * 32; else if (k_ < 768) off_ = 16384 + (k_ - 512) * 32; } \
            else { if (k_ < 64) off_ = k_ * 32; else if (k_ < 128) off_ = 4096 + (k_ - 64) * 32; else if (k_ < 384) off_ = 8192 + (k_ - 128) * 32; else if (k_ < 640) off_ = 16384 + (k_ - 384) * 32; } \
            if (off_ >= 0) { const v4u v_ = tr[q_]; *(LAS f32x4*)(tb_ + off_) = (f32x4){bflo(v_.x), bfhi(v_.x), bflo(v_.y), bfhi(v_.y)}; *(LAS f32x4*)(tb_ + off_ + 16) = (f32x4){bflo(v_.z), bfhi(v_.z), bflo(v_.w), bfhi(v_.w)}; } } \
        if (lane < 8) ((LAS float*)(tb_ + 24832))[wave * 8 + lane] = wv; } while (0)
#define SIN_OF(bs_, gi_) ((RET ? a.in[I_SRET] : a.in[I_SSSM]) + (RET ? ((size_t)((bs_) * RH + (gi_)) * RDV + wave * 64) : ((size_t)((bs_) * NH + (gi_) * 8 + wave) * 64)) * N)
#define SLOAD(dst, Sin_, j) do { const float* sp_ = (Sin_) + (size_t)(((j) / NSUB) * 16 + l15) * N + ((j) % NSUB) * 128 + 4 * g4; \
        _Pragma("unroll") for (int k_ = 0; k_ < 4; ++k_) { dst[2 * k_] = *(const f32x4*)(sp_ + 32 * k_); dst[2 * k_ + 1] = *(const f32x4*)(sp_ + 32 * k_ + 16); } } while (0)
    if (nu == 0) return;
    __syncthreads();
    { const int u0 = blockIdx.x; TLOAD(u0 >> 3, u0 & 7); TWRITE(0); SLOAD(cur, SIN_OF(u0 >> 3, u0 & 7), 0); }
    __syncthreads();
#pragma unroll 1
    for (int i = 0; i < nu; ++i) {
        const int u = (int)blockIdx.x + i * G, bs = u >> 3, gi = u & 7, un = u + G, bsn = un >> 3, gin = un & 7; const bool more = i + 1 < nu;
        const size_t Rs = (size_t)NPR + (size_t)bs * SL;
        LAS unsigned char* tb = lds + (i & 1) * TSET;
        LAS float* BT = (LAS float*)tb; LAS float* CR = (LAS float*)(tb + 4096); LAS float* XT = (LAS float*)(tb + 8192); LAS float* ZT = (LAS float*)(tb + 16384);
        LAS float* CB = (LAS float*)(tb + 24576); LAS float* WSC = (LAS float*)(tb + 24832);
        const float* Sin = SIN_OF(bs, gi); float* Sout = a.out + (RET ? O_RETS : O_SSMS) + (Sin - (RET ? a.in[I_SRET] : a.in[I_SSSM]));
        for (int pp = wave; pp < 16; pp += 8) { const int t = pp >> 2, s = pp & 3; float d = 0.f; for (int n = lane; n < N; n += 64) d += CR[t * N + n] * BT[s * N + n]; d = wave_sum(d); if (lane == 0) CB[pp] = d; }
        __syncthreads();
        if (more) TLOAD(bsn, gin);
        const float acs_t = WSC[wave * 8 + tt], acs3 = WSC[wave * 8 + 3], A3 = __expf(acs3), At = __expf(acs_t);
        float cf[4], wd[4];
#pragma unroll
        for (int s = 0; s < 4; ++s) { const float as = WSC[wave * 8 + s], ds = WSC[wave * 8 + 4 + s]; cf[s] = (s <= tt) ? __expf(acs_t - as) * ds * CB[tt * 4 + s] : 0.f; wd[s] = __expf(acs3 - as) * ds; }
        const float Dh = RET ? 0.f : a.in[I_DSKIP][gi * 8 + wave];
        bf16x8 qf[NKS];
#pragma unroll
        for (int ks = 0; ks < NKS; ++ks) { const f32x4 c0 = *(const LAS f32x4*)(CR + tt * N + 32 * ks + 4 * g4), c1 = *(const LAS f32x4*)(CR + tt * N + 32 * ks + 16 + 4 * g4);
            const float m = l15 < 4 ? At : 0.f;
            qf[ks] = __builtin_bit_cast(bf16x8, (v4u){pk2(c0.x * m, c0.y * m), pk2(c0.z * m, c0.w * m), pk2(c1.x * m, c1.y * m), pk2(c1.z * m, c1.w * m)}); }
        float ssq = 0.f; f32x4 acc = (f32x4){0.f, 0.f, 0.f, 0.f};
#define SAMP_SUB(st, j) do { const int slab_ = (j) / NSUB, sub_ = (j) % NSUB, pu_ = 64 * wave + 16 * slab_; \
        float u_[4]; _Pragma("unroll") for (int s = 0; s < 4; ++s) u_[s] = wd[s] * XT[s * 512 + pu_ + l15]; \
        float* op_ = Sout + (size_t)(slab_ * 16 + l15) * N + sub_ * 128 + 4 * g4; \
        _Pragma("unroll") for (int k = 0; k < 4; ++k) { \
            const f32x4 s0 = st[2 * k], s1 = st[2 * k + 1]; \
            const bf16x8 af = __builtin_bit_cast(bf16x8, (v4u){pk2(s0.x, s0.y), pk2(s0.z, s0.w), pk2(s1.x, s1.y), pk2(s1.z, s1.w)}); \
            acc = MFMA16(af, (NSUB == 1 || sub_ == 0) ? qf[k] : qf[(NKS - 4) + k], acc); \
            f32x4 n0 = s0 * A3, n1 = s1 * A3; \
            _Pragma("unroll") for (int s = 0; s < 4; ++s) { const f32x4 b0 = *(const LAS f32x4*)(BT + s * N + sub_ * 128 + 32 * k + 4 * g4), b1 = *(const LAS f32x4*)(BT + s * N + sub_ * 128 + 32 * k + 16 + 4 * g4); \
                n0 += b0 * u_[s]; n1 += b1 * u_[s]; } \
            *(f32x4*)(op_ + 32 * k) = n0; *(f32x4*)(op_ + 32 * k + 16) = n1; } \
        if (sub_ == NSUB - 1) { \
            _Pragma("unroll") for (int i = 0; i < 4; ++i) { const int pc = pu_ + 4 * g4 + i; \
                float y = acc[i] + cf[0] * XT[pc] + cf[1] * XT[512 + pc] + cf[2] * XT[1024 + pc] + cf[3] * XT[1536 + pc]; \
                if (!RET) { y += Dh * XT[tt * 512 + pc]; const float z = ZT[tt * 512 + pc]; y *= siluf(z); } \
                if (l15 < 4) { YL[pc * 4 + tt] = y; ssq += y * y; } } \
            acc = (f32x4){0.f, 0.f, 0.f, 0.f}; } } while (0)
#pragma unroll 1
        for (int jp = 0; jp < 2 * NSUB; ++jp) {
            SLOAD(nxt, Sin, 2 * jp + 1);
            SAMP_SUB(cur, 2 * jp);
            if (jp + 1 < 2 * NSUB) SLOAD(cur, Sin, 2 * jp + 2);
            SAMP_SUB(nxt, 2 * jp + 1);
        }
        if (more) { SLOAD(cur, SIN_OF(bsn, gin), 0); TWRITE((i + 1) & 1); }
#undef SAMP_SUB
        ssq += __shfl_xor(ssq, 16); ssq += __shfl_xor(ssq, 32);
        if (lane < 4) SQ[wave * 4 + lane] = ssq;
        __syncthreads();
        float tot = 0.f;
#pragma unroll
        for (int w = 0; w < 8; ++w) tot += SQ[w * 4 + tt];
        const float rstd = 1.0f / sqrtf(tot * (1.0f / 512.0f) + EPS);
        if (l15 < 4) {
            bf16* Yo = (bf16*)(a.ws + (RET ? WS_YR : WS_YS)) + (Rs + tt) * INNER + gi * 512;
#pragma unroll 1
            for (int slab = 0; slab < 4; ++slab) { const int pc = 64 * wave + 16 * slab + 4 * g4; float o[4];
#pragma unroll
                for (int i2 = 0; i2 < 4; ++i2) { o[i2] = YL[(pc + i2) * 4 + tt] * rstd;
                    if (RET) o[i2] *= siluf(ZT[tt * 512 + pc + i2]); else o[i2] *= a.in[I_SNW][gi * 512 + pc + i2]; }
                v2u ov; ov.x = pk2(o[0], o[1]); ov.y = pk2(o[2], o[3]); *(v2u*)(Yo + pc) = ov; }
        }
        __syncthreads();
    }
#undef TLOAD
#undef TWRITE
#undef SIN_OF
#undef SLOAD
}
__device__ __forceinline__ void samp_phase(const Args& a, LAS unsigned char* lds, int tid, int wave, int lane) {
    samp_stream<true>(a, lds, tid, wave, lane);
    samp_stream<false>(a, lds, tid, wave, lane);
}

#ifndef PROBE_DUP
#define PROBE_DUP 0
#endif
#ifndef MK_N_LAUNCHES
#define MK_N_LAUNCHES 1
#endif
constexpr int N_PHASES = 10;
template <int LO, int HI> __global__ void __launch_bounds__(NWAVES * 64, 2) fwd_kernel(Args args) {
    extern __shared__ __attribute__((aligned(16))) unsigned char lds_raw[];
    LAS unsigned char* lds = (LAS unsigned char*)lds_raw;
    const int tid = threadIdx.x, lane = tid & 63, wave = __builtin_amdgcn_readfirstlane(tid >> 6);
    const int G = gridDim.x;
    for (int u = tid; u < (LDS_BYTES - LDSCTL_OFF) / 4; u += NWAVES * 64) ((LAS unsigned*)(lds + LDSCTL_OFF))[u] = 0u;
    __syncthreads();
    unsigned* ctl = (unsigned*)(args.ws + WS_CTL);
    XcdBarrier bar; bar.bar = ctl + CW_BAR; bar.x = 0; bar.st = nullptr;
    constexpr int lo = LO, hi = HI;
    if (hi - lo > 1) bar = xcd_barrier_post(ctl + CW_BAR, (volatile LAS unsigned*)(lds + MISC_OFF) + 8);
#define IN(k) (lo <= (k) && (k) < hi)
#define IF_IN(k) if constexpr (IN(k))
#define SEAM(k) do { if constexpr (IN(k) && IN((k) + 1)) xcd_barrier(bar); } while (0)

#define PH_0 p0_prologue(args, lds, wave, lane)
#define PH_1 do { pg8::Gemm g{(const bf16*)(args.ws + WS_HN), (const bf16*)(args.ws + WS_WTIN), MT, LDP, DM, nullptr, nullptr}; pg8::StaticOrder S; S.init(MT, LDP, DM, G, (int)blockIdx.x); \
        pg8::EpiProj E{(bf16*)(args.ws + WS_PROJ), (float*)(args.ws + WS_DT), LDP, DT_TILE, (const float*)(args.ws + WS_COS), (const float*)(args.ws + WS_SIN), C_Q / 256, C_K / 256, NPR}; \
        pg8::gemm_phase<pg8::EpiProj, pg8::StaticOrder, true, true>(lds + RING_OFF, g, S, E); } while (0)
#define PH_2 p2_prep(args, lds)
#define PH_3 scan_phase(args, lds, tid, wave, lane)
#define PH_4 samp_phase(args, lds, tid, wave, lane)
#define PH_5 passC(args.ws, args.in[I_DSKIP], args.in[I_SNW], lds)
#define PH_6 do { pg8::Gemm g{(const bf16*)(args.ws + WS_YS), (const bf16*)(args.ws + WS_WTPS), MT, DM, INNER, (const bf16*)(args.ws + WS_YR), (const bf16*)(args.ws + WS_WTPR)}; pg8::DualOrder S{G, (int)blockIdx.x}; \
        pg8::EpiDual E{(const bf16*)(args.ws + WS_PROJ), LDP, C_GATE, (bf16*)(args.ws + WS_MG), (float*)(args.ws + WS_MFS), NPR / 256}; \
        pg8::gemm_phase<pg8::EpiDual, pg8::DualOrder, true, true>(lds + RING_OFF, g, S, E); } while (0)
#define PH_7 p7_merge_sample(args)
#define PH_8 do { pg8::Gemm g{(const bf16*)(args.ws + WS_MG), (const bf16*)(args.ws + WS_WTO), MT, DM, DM, nullptr, nullptr}; pg8::OutOrder S{G, (int)blockIdx.x}; \
        pg8::EpiOut2 E{(float*)(args.ws + WS_OF), (float*)(args.ws + WS_OFS), NPR / 256}; \
        pg8::gemm_phase<pg8::EpiOut2, pg8::OutOrder, true, true>(lds + RING_OFF, g, S, E); } while (0)
#define PH_9 p8_final(args, wave, lane)
#ifndef SKIPMASK
#define SKIPMASK 0
#endif
#define RUN(k) do { IF_IN(k) { if constexpr (!(((SKIPMASK) >> (k)) & 1)) PH_##k; if constexpr ((MK_N_LAUNCHES == 1) && (((PROBE_DUP) >> (k)) & 1)) { xcd_barrier(bar); PH_##k; } } SEAM(k); } while (0)
    RUN(0); RUN(1); RUN(2); RUN(3); RUN(4); RUN(5); RUN(6); RUN(7); RUN(8); RUN(9);
#undef RUN
#undef IN
#undef IF_IN
#undef SEAM
}

template <int LO, int HI> static bool setup_one() { return hipFuncSetAttribute((const void*)fwd_kernel<LO, HI>, hipFuncAttributeMaxDynamicSharedMemorySize, LDS_BYTES) == hipSuccess; }
template <int LO, int HI> static void launch_one(int grid, hipStream_t stream, const Args& a) { hipLaunchKernelGGL((fwd_kernel<LO, HI>), dim3(grid), dim3(NWAVES * 64), LDS_BYTES, stream, a); }
#if MK_N_LAUNCHES == 1
static bool setup_all() { return setup_one<0, N_PHASES>(); }
static void launch_all(int grid, hipStream_t stream, const Args& a) { launch_one<0, N_PHASES>(grid, stream, a); }
#else
static bool setup_all() { return setup_one<0, 1>() && setup_one<1, 2>() && setup_one<2, 3>() && setup_one<3, 4>() && setup_one<4, 5>() && setup_one<5, 6>() && setup_one<6, 7>() && setup_one<7, 8>() && setup_one<8, 9>() && setup_one<9, 10>(); }
template <int K> static void launch_ph(int grid, hipStream_t stream, const Args& a) { launch_one<K, K + 1>(grid, stream, a); if ((PROBE_DUP >> K) & 1) launch_one<K, K + 1>(grid, stream, a); }
static void launch_all(int grid, hipStream_t stream, const Args& a) {
    launch_ph<0>(grid, stream, a); launch_ph<1>(grid, stream, a); launch_ph<2>(grid, stream, a); launch_ph<3>(grid, stream, a); launch_ph<4>(grid, stream, a);
    launch_ph<5>(grid, stream, a); launch_ph<6>(grid, stream, a); launch_ph<7>(grid, stream, a); launch_ph<8>(grid, stream, a); launch_ph<9>(grid, stream, a); }
#endif
extern "C" void kernel_launch(void* const* d_in, const int* in_sizes, int n_in, void* d_out, int out_size, void* d_ws, size_t ws_size, hipStream_t stream) {
    static int grid = 0;
    if (grid == 0) {
        if (n_in != 17 || (size_t)out_size != O_END || ws_size < WS_END) { fprintf(stderr, "kernel_launch: unexpected shapes (n_in %d out %d ws %zu); nothing launched\n", n_in, out_size, ws_size); grid = -1; return; }
        int dev = 0, cus = 0, per_cu = 0;
        if (hipGetDevice(&dev) != hipSuccess || hipDeviceGetAttribute(&cus, hipDeviceAttributeMultiprocessorCount, dev) != hipSuccess) { grid = -1; return; }
        if (!setup_all()) { fprintf(stderr, "kernel_launch: hipFuncSetAttribute failed\n"); grid = -1; return; }
        (void)per_cu; (void)hipGetLastError();
        grid = cus;
    }
    if (grid < 0) return;
    if (hipMemsetAsync((char*)d_ws + WS_CTL, 0, CTL_ZERO_BYTES, stream) != hipSuccess) return;
    Args a{};
    for (int i = 0; i < 17; ++i) a.in[i] = (const float*)d_in[i];
    a.out = (float*)d_out; a.ws = (unsigned char*)d_ws;
    static_assert(sizeof(Args) == 160, "Args has no padding");
    a.ph_lo = 0; a.ph_hi = N_PHASES;
    launch_all(grid, stream, a);
}
#ifdef TEST_LO
template __global__ void fwd_kernel<TEST_LO, TEST_HI>(Args);
#endif
```

```cpp
#include <hip/hip_runtime.h>
#include <cstdio>
#include <cstdint>
namespace pg8 {
#define PG8_LAS __attribute__((address_space(3)))
typedef unsigned short bf16_t;
typedef short bf16x8 __attribute__((ext_vector_type(8)));
typedef float f32x4 __attribute__((ext_vector_type(4)));
typedef unsigned u32x4 __attribute__((ext_vector_type(4)));
constexpr int BM = 256, BK = 64, HALF = 128, HTB = HALF * BK * 2  , STAGE_BYTES = 8 * HTB, NXCD = 8, WGM = 8;

__host__ __device__ __forceinline__ int lds_byte(int r, int c) { const int st = (r >> 4) * 2 + (c >> 5), rr = r & 15, cc = c & 31, ob = rr * 64 + cc * 2; return st * 1024 + (ob ^ (((ob >> 9) & 1) << 5)); }
__host__ __device__ __forceinline__ void stage_rc(int b, int& R, int& C) { const int st = b / 1024, sb = b % 1024, swz = sb ^ (((sb >> 9) & 1) << 5); R = (st >> 1) * 16 + swz / 64; C = (st & 1) * 32 + (swz % 64) / 2; }
__host__ __device__ __forceinline__ int perm32(int rho) { const int n = rho >> 4, i = rho & 15; return 8 * (i >> 2) + 4 * n + (i & 3); }

struct Unit { int pm, pn, sel, k0, nt, mode; };
struct Gemm { const bf16_t* A; const bf16_t* Bt; int M, N, K; const bf16_t* A2; const bf16_t* Bt2; };

struct StaticOrder {
    int nM, nN, nwg, G, c, ntk;
    __host__ __device__ void init(int M, int N, int K, int G_, int c_) { nM = M / BM; nN = N / BM; nwg = nM * nN; G = G_; c = c_; ntk = K / BK; }
    __host__ __device__ bool next(int i, Unit& u) const {
        const long L = (long)i * G + c; if (L >= nwg) return false;
        int wgid = (int)L; { const int q = nwg / NXCD, r = nwg % NXCD, xcd = wgid % NXCD, off = wgid / NXCD; wgid = (xcd < r ? xcd * (q + 1) : r * (q + 1) + (xcd - r) * q) + off; }
        const int nig = WGM * nN, gid = wgid / nig, fm = gid * WGM, gsz = (nM - fm) < WGM ? (nM - fm) : WGM;
        u.pm = fm + ((wgid % nig) % gsz); u.pn = (wgid % nig) / gsz; u.sel = 0; u.k0 = 0; u.nt = ntk; u.mode = 0; return true;
    }
    __device__ __forceinline__ void a_ready(const Unit&) const {}
    __device__ __forceinline__ void done(const Unit&) const {}
};

__device__ __forceinline__ unsigned cvt_pk_bf16(float lo, float hi) { unsigned r; asm volatile("v_cvt_pk_bf16_f32 %0, %1, %2" : "=v"(r) : "v"(lo), "v"(hi)); return r; }
typedef float f32x2 __attribute__((ext_vector_type(2)));

constexpr int PROJ_NCT = 210;
__device__ __forceinline__ size_t toff(int row, int col, int nct) { return ((size_t)(row >> 7) * nct + (col >> 7)) * 16384 + (size_t)(row & 127) * 128 + (col & 127); }
__device__ __forceinline__ float bf_lo(unsigned w) { return __uint_as_float(w << 16); }
__device__ __forceinline__ float bf_hi(unsigned w) { return __uint_as_float(w & 0xffff0000u); }
__device__ __forceinline__ float sigmoidf_(float x) { return __builtin_amdgcn_rcpf(1.0f + __expf(-x)); }

struct EpiProj {
    static constexpr bool PERM = true, AFTER_DRAIN = false, HAS_MID = false;
    bf16_t* O; float* DT; int ldp; int dt_tile; const float* COS; const float* SIN; int qk_tile0, k_tile0, npr;
    __device__ __forceinline__ void operator()(const f32x4 (&acc)[2][2][4][2], const Unit& u, int wr, int wc, int fr, int fq) const {
        asm volatile("" : "+v"(fr), "+v"(fq));
        const int row0 = u.pm * BM + wr * 64 + fr; const unsigned lane_off = (unsigned)(fr * 256 + fq * 16);
        if (u.pn >= qk_tile0 && u.pn < qk_tile0 + 16) {
            const int col0 = u.pn * BM + wc * 32 + 8 * fq, ic = wc * 32 + 8 * fq; const float sc = u.pn >= k_tile0 ? 0.0625f : 1.0f;
#pragma unroll
            for (int ai = 0; ai < 2; ++ai)
#pragma unroll
                for (int m = 0; m < 4; ++m) { const int row = row0 + ai * HALF + m * 16, pidx = row < npr ? (row & 2047) : 2048 + (row & 3);
                    char* tb = (char*)O + (((size_t)(2 * u.pm + ai) * PROJ_NCT + 2 * u.pn) * 16384 + (wr * 64 + m * 16) * 128 + wc * 32) * 2 + lane_off;
                    const f32x4 c0 = *(const f32x4*)(COS + pidx * 128 + ic), c1 = *(const f32x4*)(COS + pidx * 128 + ic + 4), s0 = *(const f32x4*)(SIN + pidx * 128 + ic), s1 = *(const f32x4*)(SIN + pidx * 128 + ic + 4);
                    const f32x4 a0 = acc[ai][0][m][0], a1 = acc[ai][0][m][1], b0 = acc[ai][1][m][0], b1 = acc[ai][1][m][1];
                    const f32x4 o0 = (a0 * c0 - b0 * s0) * sc, o1 = (a1 * c1 - b1 * s1) * sc, p0 = (b0 * c0 + a0 * s0) * sc, p1 = (b1 * c1 + a1 * s1) * sc;
                    u32x4 w; w.x = cvt_pk_bf16(o0[0], o0[1]); w.y = cvt_pk_bf16(o0[2], o0[3]); w.z = cvt_pk_bf16(o1[0], o1[1]); w.w = cvt_pk_bf16(o1[2], o1[3]);
                    *(u32x4*)tb = w;
                    w.x = cvt_pk_bf16(p0[0], p0[1]); w.y = cvt_pk_bf16(p0[2], p0[3]); w.z = cvt_pk_bf16(p1[0], p1[1]); w.w = cvt_pk_bf16(p1[2], p1[3]);
                    *(u32x4*)(tb + 32768) = w;
                    asm volatile("" ::: "memory"); }
        } else if (u.pn != dt_tile) {
            const int col0 = u.pn * BM + wc * 32 + 8 * fq;
#pragma unroll
            for (int ai = 0; ai < 2; ++ai)
#pragma unroll
                for (int m = 0; m < 4; ++m) { char* tb = (char*)O + (((size_t)(2 * u.pm + ai) * PROJ_NCT + 2 * u.pn) * 16384 + (wr * 64 + m * 16) * 128 + wc * 32) * 2 + lane_off;
#pragma unroll
                    for (int bj = 0; bj < 2; ++bj) { const f32x4 v0 = acc[ai][bj][m][0], v1 = acc[ai][bj][m][1];
                        u32x4 w; w.x = cvt_pk_bf16(v0[0], v0[1]); w.y = cvt_pk_bf16(v0[2], v0[3]); w.z = cvt_pk_bf16(v1[0], v1[1]); w.w = cvt_pk_bf16(v1[2], v1[3]);
                        *(u32x4*)(tb + bj * 32768) = w; }
                    asm volatile("" ::: "memory"); }
        } else if (wc < 2) {
#pragma unroll
            for (int ai = 0; ai < 2; ++ai)
#pragma unroll
                for (int m = 0; m < 4; ++m) { float* rp = DT + (size_t)(row0 + ai * HALF + m * 16) * 64 + wc * 32 + 8 * fq;
                    *(f32x4*)rp = acc[ai][0][m][0]; *(f32x4*)(rp + 4) = acc[ai][0][m][1]; }
        }
    }
};
struct EpiDual {
    static constexpr bool PERM = true, AFTER_DRAIN = false, HAS_MID = true;
    const bf16_t* gate; int ldg; int gcol; bf16_t* MG; float* MFS; int prompt_panels;
    __device__ __forceinline__ void mid(f32x4 (&acc)[2][2][4][2], const Unit& u, int wr, int wc, int fr, int fq) const {
        asm volatile("" : "+v"(fr), "+v"(fq));
        const int row0 = u.pm * BM + wr * 64 + fr, col0 = u.pn * BM + wc * 32 + 8 * fq;
#pragma unroll
        for (int ai = 0; ai < 2; ++ai)
#pragma unroll
            for (int m = 0; m < 4; ++m) { const size_t r = (size_t)(row0 + ai * HALF + m * 16);
#pragma unroll
                for (int bj = 0; bj < 2; ++bj) { const int c = col0 + bj * HALF;
                    const bf16_t* gp = gate + ((size_t)(2 * u.pm + ai) * PROJ_NCT + ((gcol + c) >> 7)) * 16384 + (wr * 64 + m * 16 + fr) * 128 + wc * 32 + 8 * fq;
                    const u32x4 g1 = *(const u32x4*)gp, g2 = *(const u32x4*)(gp + 16 * 16384);
#define RAT_(a, b) ((1.0f + __expf(-(b))) * __builtin_amdgcn_rcpf(1.0f + __expf(-(a))))
                    f32x4& v0 = acc[ai][bj][m][0]; f32x4& v1 = acc[ai][bj][m][1];
                    v0[0] *= RAT_(bf_lo(g1.x), bf_lo(g2.x)); v0[1] *= RAT_(bf_hi(g1.x), bf_hi(g2.x)); v0[2] *= RAT_(bf_lo(g1.y), bf_lo(g2.y)); v0[3] *= RAT_(bf_hi(g1.y), bf_hi(g2.y));
                    v1[0] *= RAT_(bf_lo(g1.z), bf_lo(g2.z)); v1[1] *= RAT_(bf_hi(g1.z), bf_hi(g2.z)); v1[2] *= RAT_(bf_lo(g1.w), bf_lo(g2.w)); v1[3] *= RAT_(bf_hi(g1.w), bf_hi(g2.w));
#undef RAT_
                }
                asm volatile("" ::: "memory"); }
    }
    __device__ __forceinline__ void operator()(const f32x4 (&acc)[2][2][4][2], const Unit& u, int wr, int wc, int fr, int fq) const {
        asm volatile("" : "+v"(fr), "+v"(fq));
        const int row0 = u.pm * BM + wr * 64 + fr, col0 = u.pn * BM + wc * 32 + 8 * fq;
        const bool prompt = u.pm < prompt_panels; const int gc = gcol + ((prompt || u.sel) ? 2048 : 0);
#pragma unroll
        for (int ai = 0; ai < 2; ++ai)
#pragma unroll
            for (int m = 0; m < 4; ++m) { const size_t r = (size_t)(row0 + ai * HALF + m * 16);
#pragma unroll
                for (int bj = 0; bj < 2; ++bj) { const int c = col0 + bj * HALF;
                    const u32x4 gw = *(const u32x4*)(gate + ((size_t)(2 * u.pm + ai) * PROJ_NCT + ((gc + c) >> 7)) * 16384 + (wr * 64 + m * 16 + fr) * 128 + wc * 32 + 8 * fq);
                    const f32x4 v0 = acc[ai][bj][m][0], v1 = acc[ai][bj][m][1];
                    f32x4 o0, o1;
                    o0[0] = v0[0] * sigmoidf_(bf_lo(gw.x)); o0[1] = v0[1] * sigmoidf_(bf_hi(gw.x)); o0[2] = v0[2] * sigmoidf_(bf_lo(gw.y)); o0[3] = v0[3] * sigmoidf_(bf_hi(gw.y));
                    o1[0] = v1[0] * sigmoidf_(bf_lo(gw.z)); o1[1] = v1[1] * sigmoidf_(bf_hi(gw.z)); o1[2] = v1[2] * sigmoidf_(bf_lo(gw.w)); o1[3] = v1[3] * sigmoidf_(bf_hi(gw.w));
                    if (prompt) { u32x4 w; w.x = cvt_pk_bf16(o0[0], o0[1]); w.y = cvt_pk_bf16(o0[2], o0[3]); w.z = cvt_pk_bf16(o1[0], o1[1]); w.w = cvt_pk_bf16(o1[2], o1[3]);
                        *(u32x4*)(MG + r * 2048 + c) = w; }
                    else { float* d = MFS + ((size_t)(u.sel * 8 + (u.k0 >> 9)) * 512 + (r - (size_t)prompt_panels * BM)) * 2048 + c;
                        *(f32x4*)d = o0; *(f32x4*)(d + 4) = o1; } }
                asm volatile("" ::: "memory"); }
    }
};
struct EpiOut2 {
    static constexpr bool PERM = true, AFTER_DRAIN = false, HAS_MID = false;
    float* OF; float* OFS; int prompt_panels;
    __device__ __forceinline__ void operator()(const f32x4 (&acc)[2][2][4][2], const Unit& u, int wr, int wc, int fr, int fq) const {
        asm volatile("" : "+v"(fr), "+v"(fq));
        const int row0 = u.pm * BM + wr * 64 + fr, col0 = u.pn * BM + wc * 32 + 8 * fq; const bool prompt = u.pm < prompt_panels;
#pragma unroll
        for (int ai = 0; ai < 2; ++ai)
#pragma unroll
            for (int m = 0; m < 4; ++m) { const size_t r = (size_t)(row0 + ai * HALF + m * 16);
                float* rp = prompt ? OF + r * 2048 + col0 : OFS + ((size_t)(u.k0 >> 8) * 512 + (r - (size_t)prompt_panels * BM)) * 2048 + col0;
#pragma unroll
                for (int bj = 0; bj < 2; ++bj) { *(f32x4*)(rp + bj * HALF) = acc[ai][bj][m][0]; *(f32x4*)(rp + bj * HALF + 4) = acc[ai][bj][m][1]; } }
    }
};
struct DualOrder {
    int G, c;
    __device__ __forceinline__ bool next(int i, Unit& u) const {
        const int nd = c < 256 ? (256 - c + G - 1) / G : 0;
        if (i < 2 * nd) { const int j = c + (i >> 1) * G, vj = (j & 7) * 32 + (j >> 3); u.pm = vj >> 3; u.pn = vj & 7; u.sel = i & 1; u.k0 = 0; u.nt = 64; u.mode = (i & 1) ? 2 : 1; return true; }
        const int s = c + (i - 2 * nd) * G; if (s >= 256) return false;
        const int ks = s & 15; u.pm = 32 + (s >> 7); u.pn = (s >> 4) & 7; u.sel = ks >> 3; u.k0 = (ks & 7) * 512; u.nt = 8; u.mode = 0; return true;
    }
    __device__ __forceinline__ void a_ready(const Unit&) const {}
    __device__ __forceinline__ void done(const Unit&) const {}
};
struct OutOrder {
    int G, c;
    __device__ __forceinline__ bool next(int i, Unit& u) const {
        const int nd = c < 256 ? (256 - c + G - 1) / G : 0;
        if (i < nd) { const int j = c + i * G, vj = (j & 7) * 32 + (j >> 3); u.pm = vj >> 3; u.pn = vj & 7; u.sel = 0; u.k0 = 0; u.nt = 32; u.mode = 0; return true; }
        const int s = c + (i - nd) * G; if (s >= 128) return false;
        u.pm = 32 + (s >> 6); u.pn = (s >> 3) & 7; u.sel = 0; u.k0 = (s & 7) * 256; u.nt = 4; u.mode = 0; return true;
    }
    __device__ __forceinline__ void a_ready(const Unit&) const {}
    __device__ __forceinline__ void done(const Unit&) const {}
};
template <class Epi, class Sched, bool ALIGN_EPI = false, bool SP2 = false>
__device__ __forceinline__ void gemm_phase(PG8_LAS unsigned char* lds, const Gemm g, const Sched& S, const Epi& E) {
    const int tid = threadIdx.x, wid = __builtin_amdgcn_readfirstlane(tid >> 6), lane = tid & 63, wr = wid >> 2, wc = wid & 3, fr = lane & 15, fq = lane >> 4;
    const int K = g.K;
    unsigned voffA[2], voffB[2];
#pragma unroll
    for (int i = 0; i < 2; ++i) { int R, C; stage_rc(tid * 16 + i * 8192, R, C); const int Rb = Epi::PERM ? ((R & ~31) + perm32(R & 31)) : R;
        voffA[i] = (unsigned)(R * K + C) * 2u; voffB[i] = (unsigned)(Rb * K + C) * 2u; }
    const size_t kstep = (size_t)(BK * 2);
    const size_t hstep = (size_t)HALF * K * 2;
    const size_t tstep = 2 * hstep;
    const unsigned ldsw = (unsigned)wid * 1024u;
    const int aoff = lds_byte(wr * 64 + fr, fq * 8), boff = lds_byte(wc * 32 + fr, fq * 8);
#define PG8_SA(b, h) (((b) * 2 + (h)) * HTB)
#define PG8_SB(b, h) ((4 + (b) * 2 + (h)) * HTB)
#define PG8_STAGE(bufoff, gbase, voff) do { _Pragma("unroll") for (int _i = 0; _i < 2; ++_i) \
        __builtin_amdgcn_global_load_lds((const unsigned*)((const char*)(gbase) + (voff)[_i]), (PG8_LAS unsigned*)(lds + (bufoff) + ldsw + _i * 8192), 16, 0, 0); } while (0)
#define PG8_LDA(dst, b, h) do { _Pragma("unroll") for (int m = 0; m < 4; ++m) _Pragma("unroll") for (int k = 0; k < 2; ++k) dst[m][k] = *(const PG8_LAS bf16x8*)(lds + PG8_SA(b, h) + aoff + m * 2048 + k * 1024); } while (0)
#define PG8_LDB(dst, b, h) do { _Pragma("unroll") for (int n = 0; n < 2; ++n) _Pragma("unroll") for (int k = 0; k < 2; ++k) dst[n][k] = *(const PG8_LAS bf16x8*)(lds + PG8_SB(b, h) + boff + n * 2048 + k * 1024); } while (0)
#define PG8_MMA(ai, bj, At, Bt) do { __builtin_amdgcn_s_setprio(1); _Pragma("unroll") for (int m = 0; m < 4; ++m) _Pragma("unroll") for (int n = 0; n < 2; ++n) _Pragma("unroll") for (int k = 0; k < 2; ++k) \
        acc[ai][bj][m][n] = __builtin_amdgcn_mfma_f32_16x16x32_bf16(Bt[n][k], At[m][k], acc[ai][bj][m][n], 0, 0, 0); __builtin_amdgcn_s_setprio(0); } while (0)
#define PG8_WAIT_V(n) asm volatile("s_waitcnt vmcnt(" #n ")" ::: "memory")
#define PG8_WAIT_L(n) asm volatile("s_waitcnt lgkmcnt(" #n ")" ::: "memory")
#define PG8_BAR __builtin_amdgcn_s_barrier()
#define PG8_SCHED __builtin_amdgcn_sched_barrier(0)
    Unit cur, nxt; int ui = 0;
    if (!S.next(0, cur)) return;
    f32x4 acc[2][2][4][2];
#pragma unroll
    for (int a = 0; a < 2; ++a)
#pragma unroll
        for (int b = 0; b < 2; ++b)
#pragma unroll
            for (int m = 0; m < 4; ++m)
#pragma unroll
                for (int n = 0; n < 2; ++n) acc[a][b][m][n] = (f32x4){0.f, 0.f, 0.f, 0.f};
    bf16x8 At[4][2], B0[2][2], B1[2][2];
    const char* cA = (const char*)(cur.sel ? g.A2 : g.A) + (size_t)cur.pm * tstep + (size_t)cur.k0 * 2; const char* cB = (const char*)(cur.sel ? g.Bt2 : g.Bt) + (size_t)cur.pn * tstep + (size_t)cur.k0 * 2;
    S.a_ready(cur);
    if constexpr (SP2) {
        PG8_STAGE(PG8_SB(0, 0), cB, voffB); PG8_STAGE(PG8_SB(0, 1), cB + hstep, voffB); PG8_STAGE(PG8_SA(0, 0), cA, voffA); PG8_STAGE(PG8_SA(0, 1), cA + hstep, voffA);
        if (wr == 1) PG8_BAR;
        PG8_WAIT_V(2); PG8_BAR;
        PG8_STAGE(PG8_SB(1, 0), cB + kstep, voffB); PG8_STAGE(PG8_SA(1, 0), cA + kstep, voffA); PG8_STAGE(PG8_SB(1, 1), cB + hstep + kstep, voffB);
        PG8_WAIT_V(6); PG8_BAR;
    } else {
        PG8_STAGE(PG8_SB(0, 0), cB, voffB); PG8_STAGE(PG8_SA(0, 0), cA, voffA); PG8_STAGE(PG8_SB(0, 1), cB + hstep, voffB); PG8_STAGE(PG8_SA(0, 1), cA + hstep, voffA);
        if (wr == 1) PG8_BAR;
        PG8_WAIT_V(4); PG8_BAR;
        PG8_STAGE(PG8_SB(1, 0), cB + kstep, voffB); PG8_STAGE(PG8_SA(1, 0), cA + kstep, voffA); PG8_STAGE(PG8_SB(1, 1), cB + hstep + kstep, voffB);
        PG8_WAIT_V(6); PG8_BAR;
    }
    for (;;) {
        const bool has_next = S.next(ui + 1, nxt);
        const char* nA = has_next ? (const char*)(nxt.sel ? g.A2 : g.A) + (size_t)nxt.pm * tstep + (size_t)nxt.k0 * 2 : cA; const char* nB = has_next ? (const char*)(nxt.sel ? g.Bt2 : g.Bt) + (size_t)nxt.pn * tstep + (size_t)nxt.k0 * 2 : cB;
        const int nt = cur.nt;
        for (int t = 0; t < nt; t += 2) {
            const bool last = (t == nt - 2);
            const char* a1 = cA + (size_t)(t + 1) * kstep;
            const char* a2 = last ? nA : cA + (size_t)(t + 2) * kstep; const char* b2 = last ? nB : cB + (size_t)(t + 2) * kstep;
            const char* a3 = a2 + kstep; const char* b3 = b2 + kstep;
            if (last && has_next) S.a_ready(nxt);
            if constexpr (SP2) {
            PG8_LDB(B0, 0, 0); PG8_LDB(B1, 0, 1); PG8_SCHED; PG8_LDA(At, 0, 0); PG8_STAGE(PG8_SA(1, 1), a1 + hstep, voffA);
            PG8_WAIT_V(8); PG8_WAIT_L(0); PG8_BAR; PG8_MMA(0, 0, At, B0); PG8_MMA(0, 1, At, B1); PG8_BAR; PG8_SCHED;
            PG8_LDA(At, 0, 1); PG8_STAGE(PG8_SB(0, 0), b2, voffB); PG8_STAGE(PG8_SB(0, 1), b2 + hstep, voffB); PG8_STAGE(PG8_SA(0, 0), a2, voffA);
            PG8_WAIT_V(8); PG8_WAIT_L(0); PG8_BAR; PG8_MMA(1, 0, At, B0); PG8_MMA(1, 1, At, B1); PG8_BAR; PG8_SCHED;
            PG8_LDB(B0, 1, 0); PG8_LDB(B1, 1, 1); PG8_SCHED; PG8_LDA(At, 1, 0); PG8_STAGE(PG8_SA(0, 1), a2 + hstep, voffA);
            PG8_WAIT_V(8); PG8_WAIT_L(0); PG8_BAR; PG8_MMA(0, 0, At, B0); PG8_MMA(0, 1, At, B1); PG8_BAR; PG8_SCHED;
            PG8_LDA(At, 1, 1); PG8_STAGE(PG8_SB(1, 0), b3, voffB); PG8_STAGE(PG8_SB(1, 1), b3 + hstep, voffB); PG8_STAGE(PG8_SA(1, 0), a3, voffA);
            PG8_WAIT_V(8); PG8_WAIT_L(0); PG8_BAR; PG8_MMA(1, 0, At, B0); PG8_MMA(1, 1, At, B1); PG8_BAR; PG8_SCHED;
            } else {
            PG8_LDB(B0, 0, 0); PG8_SCHED; PG8_LDA(At, 0, 0); PG8_STAGE(PG8_SA(1, 1), a1 + hstep, voffA);
            PG8_WAIT_L(8); PG8_BAR; PG8_WAIT_L(0); PG8_MMA(0, 0, At, B0); PG8_BAR; PG8_SCHED;
            PG8_LDB(B1, 0, 1); PG8_STAGE(PG8_SB(0, 0), b2, voffB);
            PG8_BAR; PG8_WAIT_L(0); PG8_MMA(0, 1, At, B1); PG8_BAR;
            PG8_LDA(At, 0, 1); PG8_STAGE(PG8_SA(0, 0), a2, voffA);
            PG8_BAR; PG8_WAIT_L(0); PG8_MMA(1, 0, At, B0); PG8_BAR; PG8_SCHED;
            PG8_STAGE(PG8_SB(0, 1), b2 + hstep, voffB);
            PG8_WAIT_V(6); PG8_BAR; PG8_MMA(1, 1, At, B1); PG8_BAR;
            PG8_LDB(B0, 1, 0); PG8_SCHED; PG8_LDA(At, 1, 0); PG8_STAGE(PG8_SA(0, 1), a2 + hstep, voffA);
            PG8_WAIT_L(8); PG8_BAR; PG8_WAIT_L(0); PG8_MMA(0, 0, At, B0); PG8_BAR; PG8_SCHED;
            PG8_LDB(B1, 1, 1); PG8_STAGE(PG8_SB(1, 0), b3, voffB);
            PG8_BAR; PG8_WAIT_L(0); PG8_MMA(0, 1, At, B1); PG8_BAR;
            PG8_LDA(At, 1, 1); PG8_STAGE(PG8_SA(1, 0), a3, voffA);
            PG8_BAR; PG8_WAIT_L(0); PG8_MMA(1, 0, At, B0); PG8_BAR; PG8_SCHED;
            PG8_STAGE(PG8_SB(1, 1), b3 + hstep, voffB);
            PG8_WAIT_V(6); PG8_BAR; PG8_MMA(1, 1, At, B1); PG8_BAR;
            }
        }
        if constexpr (ALIGN_EPI) { if (wr == 0) PG8_BAR; }
        bool keep = false;
        if constexpr (Epi::HAS_MID) { if (cur.mode == 1) { E.mid(acc, cur, wr, wc, fr, fq); keep = true; } }
        if constexpr (!Epi::AFTER_DRAIN) { if (!keep) { E(acc, cur, wr, wc, fr, fq); S.done(cur); } }
        if (!has_next) break;
        if (!keep) {
#pragma unroll
        for (int a = 0; a < 2; ++a)
#pragma unroll
            for (int b = 0; b < 2; ++b)
#pragma unroll
                for (int m = 0; m < 4; ++m)
#pragma unroll
                    for (int n = 0; n < 2; ++n) acc[a][b][m][n] = (f32x4){0.f, 0.f, 0.f, 0.f};
        }
        cur = nxt; cA = nA; cB = nB; ++ui;
        if constexpr (ALIGN_EPI) { if (wr == 1) PG8_BAR; }
    }
    PG8_WAIT_V(0);
    if constexpr (!ALIGN_EPI) { if (wr == 0) PG8_BAR; }
    PG8_BAR;
    if constexpr (Epi::AFTER_DRAIN) { E.fused(acc, cur, wr, wc, fr, fq, lds, wid, lane); S.done(cur); }
#undef PG8_SA
#undef PG8_SB
#undef PG8_STAGE
#undef PG8_LDA
#undef PG8_LDB
#undef PG8_MMA
#undef PG8_WAIT_V
#undef PG8_WAIT_L
#undef PG8_BAR
#undef PG8_SCHED
}
}

#define GAS __attribute__((address_space(1)))
#define LAS __attribute__((address_space(3)))
typedef unsigned short bf16;
typedef unsigned v4u __attribute__((ext_vector_type(4)));
typedef unsigned v2u __attribute__((ext_vector_type(2)));
typedef float f32x4 __attribute__((ext_vector_type(4)));
typedef short bf16x8 __attribute__((ext_vector_type(8)));

constexpr int NWAVES = 8;
constexpr int DM = 2048;
constexpr int NPR = 8192, NSM = 512, MT = NPR + NSM;
constexpr int SEQ = 2048, PB = 4, SB = 128, SL = 4, PAST = 16384;
constexpr int INNER = 4096, CONVD = 6144, NH = 64, NG = 8, NST = 128;
constexpr int RH = 8, RDK = 256, RDV = 512;
constexpr int IN_DIM = 26688, LDP = 26880, NTILE_IN = LDP / 256, DT_TILE = 104;
constexpr int C_Z = 0, C_XBC = 4096, C_Q = 10240, C_K = 12288, C_V = 14336, C_G = 18432, C_GATE = 22528, C_DT = 26624;
constexpr float EPS = 1e-6f;
constexpr int NCT_P = LDP / 128, NCT_X = CONVD / 128; static_assert(NCT_P == pg8::PROJ_NCT, "PROJ tiles");

constexpr size_t MiB = 1u << 20;
constexpr size_t WS_CTL = 0, CTL_ZERO_BYTES = 1 * MiB;
constexpr size_t WS_WTIN = 1 * MiB;
constexpr size_t WS_WTPS = 106 * MiB;
constexpr size_t WS_WTPR = 122 * MiB;
constexpr size_t WS_WTO  = 138 * MiB;
constexpr size_t WS_HN   = 146 * MiB;
constexpr size_t WS_PROJ = 180 * MiB;
constexpr size_t WS_DT   = 627 * MiB;
constexpr size_t WS_DTV  = 630 * MiB;
constexpr size_t WS_LA   = 633 * MiB;
constexpr size_t WS_XBCA = 636 * MiB;
constexpr size_t WS_YS   = 738 * MiB;
constexpr size_t WS_YR   = 806 * MiB;
constexpr size_t WS_MF   = 874 * MiB;
constexpr size_t WS_MG   = 942 * MiB;
constexpr size_t WS_OF   = 976 * MiB;
constexpr size_t WS_YSP0 = 1044 * MiB, WS_YSP1 = 1180 * MiB;
constexpr size_t WS_YRP0 = 1316 * MiB, WS_YRP1 = 1452 * MiB, WS_YRP2 = 1588 * MiB, WS_YRP3 = 1724 * MiB;
constexpr size_t WS_ACS  = 1860 * MiB;
constexpr size_t WS_MFS  = 1863 * MiB;
constexpr size_t WS_OFS  = 1927 * MiB;
constexpr size_t WS_COS  = 1959 * MiB, WS_SIN = 1961 * MiB;
constexpr size_t WS_END  = 1963 * MiB;
constexpr size_t WS_STS = WS_YSP0, WS_SPS = WS_YSP0 + 64 * MiB;
constexpr size_t WS_STR = WS_YSP1, WS_SPR = WS_YRP0;
static_assert(WS_WTIN + (size_t)LDP * DM * 2 <= WS_WTPS && WS_PROJ + (size_t)MT * LDP * 2 <= WS_DT && WS_XBCA + (size_t)MT * CONVD * 2 <= WS_YS, "ws map");
constexpr int CW_TMO = 0, CW_BAR = 4096;

constexpr size_t O_YP = 0, O_YS = 16777216, O_CONVP = O_YS + 1048576, O_SSMP = O_CONVP + 73728, O_RETP = O_SSMP + 2097152,
                 O_CONVS = O_RETP + 4194304, O_SSMS = O_CONVS + 2359296, O_RETS = O_SSMS + 67108864, O_END = O_RETS + 134217728;

constexpr int RING_OFF = 0, RING_BYTES = 131072, LDSCTL_OFF = 147456, MISC_OFF = LDSCTL_OFF + 320, LDS_BYTES = 163840;

#define LDS_WAIT() asm volatile("s_waitcnt lgkmcnt(0)" ::: "memory")
#define VM_WAIT() asm volatile("s_waitcnt vmcnt(0)" ::: "memory")
__device__ __forceinline__ unsigned f2bf(float f) { unsigned u = __builtin_bit_cast(unsigned, f); return (u + 0x7fffu + ((u >> 16) & 1u)) >> 16; }
typedef __bf16 hwbf2 __attribute__((ext_vector_type(2)));
typedef float hwf2 __attribute__((ext_vector_type(2)));
__device__ __forceinline__ unsigned pk2(float lo, float hi) { const hwf2 v = {lo, hi}; return __builtin_bit_cast(unsigned, __builtin_convertvector(v, hwbf2)); }
__device__ __forceinline__ size_t toff(int row, int col, int nct) { return ((size_t)(row >> 7) * nct + (col >> 7)) * 16384 + (size_t)(row & 127) * 128 + (col & 127); }
__device__ __forceinline__ float bflo(unsigned w) { return __uint_as_float(w << 16); }
__device__ __forceinline__ float bfhi(unsigned w) { return __uint_as_float(w & 0xffff0000u); }
__device__ __forceinline__ float bf2f(bf16 b) { return __uint_as_float(((unsigned)b) << 16); }
__device__ __forceinline__ float sigm(float x) { return __builtin_amdgcn_rcpf(1.0f + __expf(-x)); }
__device__ __forceinline__ float siluf(float x) { return x * __builtin_amdgcn_rcpf(1.0f + __expf(-x)); }
__device__ __forceinline__ float wave_sum(float v) {
#pragma unroll
    for (int o = 1; o < 64; o <<= 1) v += __shfl_xor(v, o);
    return v;
}
#define XB_TMO      128
#define XB_XCNT(j)  (256  + 64 * (j))
#define XB_XSUB(j)  (1280 + 64 * (j))
#define XB_XGEN(j)  (2304 + 64 * (j))
#define XB_TOP      3328
#define XB_TOPGEN   3392
#define XCD_BAR_WORDS 3456
#define XB_SPIN_CAP (1u << 18)

__device__ __forceinline__ unsigned xb_ld(unsigned* p)              { return __hip_atomic_load(p, __ATOMIC_RELAXED, __HIP_MEMORY_SCOPE_AGENT); }
__device__ __forceinline__ unsigned xb_add(unsigned* p, unsigned v) { return __hip_atomic_fetch_add(p, v, __ATOMIC_RELAXED, __HIP_MEMORY_SCOPE_AGENT); }
__device__ __forceinline__ unsigned xb_xcc_id() { return (unsigned)__builtin_amdgcn_s_getreg((3 << 11) | 20) & 0xFu; }
#define XB_SPIN(cond, bar) do { unsigned _sp = 0; while (cond) { __builtin_amdgcn_s_sleep(1); \
    if ((++_sp & 255u) == 0u) { if (xb_ld(&(bar)[XB_TMO])) break; if (_sp > XB_SPIN_CAP) { atomicAdd(&(bar)[XB_TMO], 1u); break; } } } } while (0)

struct XcdBarrier {
    unsigned* bar; unsigned x;
    volatile LAS unsigned* st;
};

__device__ __forceinline__ XcdBarrier xcd_barrier_post(unsigned* bar, volatile LAS unsigned* st) {
    XcdBarrier b; b.bar = bar; b.x = xb_xcc_id(); b.st = st;
    if (threadIdx.x == 0) (void)xb_add(&bar[XB_XCNT(b.x)], 1u);
    return b;
}
__device__ __forceinline__ void xcd_barrier_complete(unsigned* bar, unsigned x, unsigned& nloc, unsigned& nx) {
    const unsigned G = gridDim.x * gridDim.y * gridDim.z;
    unsigned sum, cnt, mine, sp = 0u;
    for (;;) {
        sum = 0u; cnt = 0u; mine = 0u;
#pragma unroll
        for (unsigned j = 0; j < 16; ++j) { const unsigned c = xb_ld(&bar[XB_XCNT(j)]); sum += c; cnt += (c > 0u) ? 1u : 0u; mine = (j == x) ? c : mine; }
        if (sum == G) break;
        __builtin_amdgcn_s_sleep(1);
        if ((++sp & 255u) == 0u) { if (xb_ld(&bar[XB_TMO])) break; if (sp > XB_SPIN_CAP) { atomicAdd(&bar[XB_TMO], 1u); break; } }
    }
    nloc = mine > 0u ? mine : 1u; nx = cnt > 0u ? cnt : 1u;
}

__device__ __forceinline__ void xcd_barrier(const XcdBarrier& b) {
    asm volatile("s_waitcnt vmcnt(0)" ::: "memory");
    __syncthreads();
    if (threadIdx.x == 0) {
        unsigned* bar = b.bar;
        __builtin_amdgcn_s_waitcnt(0);
        unsigned nloc = b.st[0], nx = b.st[1];
        if (nloc == 0u) { xcd_barrier_complete(bar, b.x, nloc, nx); b.st[0] = nloc; b.st[1] = nx; }
        const unsigned old = xb_add(&bar[XB_XSUB(b.x)], 1u);
        const unsigned gen = old / nloc;
        if (old + 1u == (gen + 1u) * nloc) {
            __builtin_amdgcn_fence(__ATOMIC_RELEASE, "agent");
            asm volatile("s_waitcnt vmcnt(0)" ::: "memory");
            const unsigned og = xb_add(&bar[XB_TOP], 1u);
            const unsigned tg = og / nx;
            if (og + 1u == (tg + 1u) * nx) xb_add(&bar[XB_TOPGEN], 1u);
            else XB_SPIN(xb_ld(&bar[XB_TOPGEN]) == tg, bar);
            __builtin_amdgcn_fence(__ATOMIC_ACQUIRE, "agent");
            xb_add(&bar[XB_XGEN(b.x)], 1u);
            asm volatile("s_waitcnt vmcnt(0)" ::: "memory");
        } else {
            XB_SPIN(xb_ld(&bar[XB_XGEN(b.x)]) == gen, bar);
            __builtin_amdgcn_fence(__ATOMIC_ACQUIRE, "agent");
            asm volatile("s_waitcnt vmcnt(0)" ::: "memory");
        }
    }
    __syncthreads();
}

struct Args { const float* in[17]; float* out; unsigned char* ws; int ph_lo, ph_hi; };
enum { I_XP = 0, I_XS, I_CCONV, I_SSSM, I_SRET, I_WPRE, I_WIN, I_CONVW, I_CONVB, I_DTB, I_ALOG, I_DSKIP, I_SNW, I_WPS, I_WPR, I_WOUT, I_WPOST };

__device__ __forceinline__ void p0_transpose_item(const float* W, int K, int N, bf16* WT, int k0, int n0, int dst_row0, LAS float* scr, int lane) {
    float tv[64];
#pragma unroll
    for (int i = 0; i < 64; ++i) tv[i] = W[(size_t)(k0 + i) * N + n0 + lane];
#pragma unroll
    for (int i = 0; i < 64; ++i) scr[i * 65 + lane] = tv[i];
    LDS_WAIT(); asm volatile("" ::: "memory");
    const int c = lane & 7;
#pragma unroll
    for (int j = 0; j < 8; ++j) { const int n = (lane >> 3) + 8 * j; const LAS float* s = scr + (8 * c) * 65 + n;
        v4u o; o.x = pk2(s[0 * 65], s[1 * 65]); o.y = pk2(s[2 * 65], s[3 * 65]); o.z = pk2(s[4 * 65], s[5 * 65]); o.w = pk2(s[6 * 65], s[7 * 65]);
        *(GAS v4u*)(WT + (size_t)(dst_row0 + n) * K + k0 + 8 * c) = o; }
    LDS_WAIT(); asm volatile("" ::: "memory");
}
__device__ __forceinline__ const float* x_row(const Args& a, int m) { return m < NPR ? a.in[I_XP] + (size_t)m * DM : a.in[I_XS] + (size_t)(m - NPR) * DM; }

__device__ __forceinline__ void p0_prologue(const Args& a, LAS unsigned char* lds, int wave, int lane) {
    LAS float* scr = (LAS float*)(lds + RING_OFF + wave * 16896);
    const int gw = blockIdx.x * NWAVES + wave, NGW = gridDim.x * NWAVES;
    bf16* WTIN = (bf16*)(a.ws + WS_WTIN); bf16* WTPS = (bf16*)(a.ws + WS_WTPS); bf16* WTPR = (bf16*)(a.ws + WS_WTPR); bf16* WTO = (bf16*)(a.ws + WS_WTO);
    constexpr int NB_IN = IN_DIM / 64;
    constexpr int I_IN = (DM / 64) * NB_IN, I_PS = (INNER / 64) * (DM / 64), I_PR = I_PS, I_O = (DM / 64) * (DM / 64);
    constexpr int NITEMS = I_IN + I_PS + I_PR + I_O;
    for (int it = gw; it < NITEMS; it += NGW) {
        int r = it;
        if (r < I_IN) { const int kb = r / NB_IN, nb = r % NB_IN, n0 = 64 * nb; const int d0 = n0 < 10240 ? n0 : (n0 < 10304 ? n0 + 16384 : n0 - 64);
            p0_transpose_item(a.in[I_WIN], DM, IN_DIM, WTIN, 64 * kb, n0, d0, scr, lane); continue; }
        r -= I_IN;
        if (r < I_PS) { const int kb = r / (DM / 64), nb = r % (DM / 64); p0_transpose_item(a.in[I_WPS], INNER, DM, WTPS, 64 * kb, 64 * nb, 64 * nb, scr, lane); continue; }
        r -= I_PS;
        if (r < I_PR) { const int kb = r / (DM / 64), nb = r % (DM / 64); p0_transpose_item(a.in[I_WPR], INNER, DM, WTPR, 64 * kb, 64 * nb, 64 * nb, scr, lane); continue; }
        r -= I_PR;
        { const int kb = r / (DM / 64), nb = r % (DM / 64); p0_transpose_item(a.in[I_WOUT], DM, DM, WTO, 64 * kb, 64 * nb, 64 * nb, scr, lane); }
    }
    { GAS v4u* z = (GAS v4u*)(WTIN + (size_t)IN_DIM * DM); const int nz = (LDP - IN_DIM) * DM / 8;
      for (int i = blockIdx.x * 512 + threadIdx.x; i < nz; i += gridDim.x * 512) z[i] = (v4u){0u, 0u, 0u, 0u}; }
    { float* COS = (float*)(a.ws + WS_COS); float* SIN = (float*)(a.ws + WS_SIN);
      for (int i = blockIdx.x * 512 + threadIdx.x; i < 2052 * 128; i += gridDim.x * 512) { const int pi = i >> 7, f = i & 127, pos = pi < 2048 ? pi : PAST + (pi - 2048);
          const double inv = exp2(-(double)f * (13.287712379549449 / 128.0)), ang = (double)pos * inv; COS[i] = (float)cos(ang); SIN[i] = (float)sin(ang); } }
    bf16* HN = (bf16*)(a.ws + WS_HN);
    const GAS f32x4* wp = (const GAS f32x4*)a.in[I_WPRE] + lane;
    for (int m = gw; m < MT; m += NGW) {
        const GAS f32x4* xr = (const GAS f32x4*)x_row(a, m) + lane;
        f32x4 v[8]; float s = 0.f;
#pragma unroll
        for (int j = 0; j < 8; ++j) { v[j] = xr[64 * j]; s += (v[j].x * v[j].x + v[j].y * v[j].y) + (v[j].z * v[j].z + v[j].w * v[j].w); }
        const float rstd = 1.0f / sqrtf(wave_sum(s) * (1.0f / DM) + EPS);
        GAS v2u* o8 = (GAS v2u*)(HN + (size_t)m * DM) + lane;
#pragma unroll
        for (int j = 0; j < 8; ++j) { const f32x4 w = wp[64 * j]; v2u o; o.x = pk2(v[j].x * rstd * w.x, v[j].y * rstd * w.y); o.y = pk2(v[j].z * rstd * w.z, v[j].w * rstd * w.w); o8[64 * j] = o; }
    }
}

__device__ __forceinline__ void p2_prep(const Args& a, LAS unsigned char* lds) {
    const bf16* PROJ = (const bf16*)(a.ws + WS_PROJ); bf16* PROJW = (bf16*)(a.ws + WS_PROJ);
    bf16* XBCA = (bf16*)(a.ws + WS_XBCA);
    const size_t gt = (size_t)blockIdx.x * 512 + threadIdx.x, NT = (size_t)gridDim.x * 512;
    const float* cw = a.in[I_CONVW]; const float* cb = a.in[I_CONVB]; const float* cache = a.in[I_CCONV];
    for (size_t it = gt; it < (size_t)(MT / 32) * (CONVD / 8); it += NT) {
        const int cg = (int)(it % (CONVD / 8)), seg = (int)(it / (CONVD / 8)), j0 = cg * 8, m0 = seg * 32;
        float w[4][8], bs[8], x0[8], x1[8], x2[8];
#pragma unroll
        for (int e = 0; e < 8; ++e) { bs[e] = cb[j0 + e];
#pragma unroll
            for (int tap = 0; tap < 4; ++tap) w[tap][e] = cw[tap * CONVD + j0 + e]; }
#define UNPK8(dst, v) do { dst[0] = bflo(v.x); dst[1] = bfhi(v.x); dst[2] = bflo(v.y); dst[3] = bfhi(v.y); dst[4] = bflo(v.z); dst[5] = bfhi(v.z); dst[6] = bflo(v.w); dst[7] = bfhi(v.w); } while (0)
        if (m0 < NPR && (m0 % SEQ) != 0) { const v4u v0 = *(const v4u*)(PROJ + toff(m0 - 3, C_XBC + j0, NCT_P)), v1 = *(const v4u*)(PROJ + toff(m0 - 2, C_XBC + j0, NCT_P)), v2 = *(const v4u*)(PROJ + toff(m0 - 1, C_XBC + j0, NCT_P));
            UNPK8(x0, v0); UNPK8(x1, v1); UNPK8(x2, v2); }
        else {
#pragma unroll
            for (int e = 0; e < 8; ++e) { x0[e] = 0.f; x1[e] = 0.f; x2[e] = 0.f; } }
#pragma unroll 1
        for (int r0 = 0; r0 < 32; r0 += 8) { v4u vv[8];
#pragma unroll
          for (int q = 0; q < 8; ++q) vv[q] = *(const v4u*)(PROJ + toff(m0 + r0 + q, C_XBC + j0, NCT_P));
#pragma unroll
          for (int q = 0; q < 8; ++q) { const int m = m0 + r0 + q;
            if (m >= NPR && ((m - NPR) % SL) == 0) { const float* cp = cache + (size_t)((m - NPR) / SL) * 3 * CONVD + j0;
#pragma unroll
                for (int e = 0; e < 8; ++e) { x0[e] = cp[e]; x1[e] = cp[CONVD + e]; x2[e] = cp[2 * CONVD + e]; } }
            const v4u v = vv[q]; float x3[8]; UNPK8(x3, v);
            float o[8];
#pragma unroll
            for (int e = 0; e < 8; ++e) { o[e] = siluf(bs[e] + w[0][e] * x0[e] + w[1][e] * x1[e] + w[2][e] * x2[e] + w[3][e] * x3[e]); x0[e] = x1[e]; x1[e] = x2[e]; x2[e] = x3[e]; }
            v4u ov; ov.x = pk2(o[0], o[1]); ov.y = pk2(o[2], o[3]); ov.z = pk2(o[4], o[5]); ov.w = pk2(o[6], o[7]);
            *(v4u*)(XBCA + toff(m, j0, NCT_X)) = ov; } }
#undef UNPK8
    }
    for (size_t i = gt; i < (size_t)(PB + SB) * 3 * CONVD; i += NT) {
        const int j = (int)(i % CONVD), bi = (int)(i / CONVD), ii = bi % 3, b = bi / 3;
        if (b < PB) a.out[O_CONVP + ((size_t)b * 3 + ii) * CONVD + j] = bf2f(PROJ[toff(b * SEQ + SEQ - 3 + ii, C_XBC + j, NCT_P)]);
        else { const int bs = b - PB; a.out[O_CONVS + ((size_t)bs * 3 + ii) * CONVD + j] = bf2f(PROJ[toff(NPR + bs * SL + 1 + ii, C_XBC + j, NCT_P)]); }
    }
    { const float* DT = (const float*)(a.ws + WS_DT); float* DTV = (float*)(a.ws + WS_DTV); float* LA = (float*)(a.ws + WS_LA);
      for (size_t i = gt; i < (size_t)MT * NH; i += NT) { const int h = (int)(i & 63); const float x = DT[i] + a.in[I_DTB][h];
          const float sp = x > 20.f ? x : log1pf(expf(x)); DTV[i] = sp; LA[i] = -sp * expf(a.in[I_ALOG][h]); }
      float* ACS = (float*)(a.ws + WS_ACS); const int lane = threadIdx.x & 63, wv = threadIdx.x >> 6;
      const float bias = a.in[I_DTB][lane], an = -expf(a.in[I_ALOG][lane]);
      LAS float* WT = (LAS float*)(lds + 8192);
      for (int ck = blockIdx.x; ck < NPR / 128; ck += gridDim.x) { float cs[16]; float acc = 0.f;
#pragma unroll
          for (int e = 0; e < 16; ++e) cs[e] = DT[(size_t)(ck * 128 + wv * 16 + e) * NH + lane] + bias;
#pragma unroll
          for (int e = 0; e < 16; ++e) { const float sp = cs[e] > 20.f ? cs[e] : log1pf(expf(cs[e])); acc += sp * an; cs[e] = acc; }
          __syncthreads(); WT[wv * 64 + lane] = acc; __syncthreads();
          float off = 0.f;
#pragma unroll
          for (int w2 = 0; w2 < 8; ++w2) off += (w2 < wv) ? WT[w2 * 64 + lane] : 0.f;
#pragma unroll
          for (int e = 0; e < 16; ++e) ACS[(size_t)(ck * 128 + wv * 16 + e) * NH + lane] = off + cs[e]; } }
}

__device__ __forceinline__ void p8_final(const Args& a, int wave, int lane) {
    const float* OF = (const float*)(a.ws + WS_OF);
    const int gw = blockIdx.x * NWAVES + wave, NGW = gridDim.x * NWAVES;
    const GAS f32x4* wp = (const GAS f32x4*)a.in[I_WPOST] + lane;
    for (int m = gw; m < MT; m += NGW) {
        const GAS f32x4* orow = (const GAS f32x4*)(OF + (size_t)m * DM) + lane; const GAS f32x4* xr = (const GAS f32x4*)x_row(a, m) + lane;
        f32x4 v[8]; float s = 0.f;
#pragma unroll
        for (int j = 0; j < 8; ++j) {
            if (m < NPR) v[j] = orow[64 * j];
            else { const GAS f32x4* ps = (const GAS f32x4*)((const float*)(a.ws + WS_OFS) + (size_t)(m - NPR) * DM) + lane + 64 * j; v[j] = ps[0];
#pragma unroll
                for (int ks = 1; ks < 8; ++ks) v[j] += ps[(size_t)ks * (NSM * DM / 4)]; }
            s += (v[j].x * v[j].x + v[j].y * v[j].y) + (v[j].z * v[j].z + v[j].w * v[j].w); }
        const float rstd = 1.0f / sqrtf(wave_sum(s) * (1.0f / DM) + EPS);
        GAS f32x4* yo = (GAS f32x4*)(a.out + (size_t)m * DM) + lane;
#pragma unroll
        for (int j = 0; j < 8; ++j) { const f32x4 w = wp[64 * j], x = xr[64 * j]; yo[64 * j] = x + v[j] * rstd * w; }
    }
}

__device__ __forceinline__ void p7_merge_sample(const Args& a) {
    const f32x4* src = (const f32x4*)(a.ws + WS_MFS); v4u* dst = (v4u*)((bf16*)(a.ws + WS_MG) + (size_t)NPR * DM);
    for (size_t i = (size_t)blockIdx.x * 512 + threadIdx.x; i < (size_t)NSM * DM / 8; i += (size_t)gridDim.x * 512) { f32x4 x0 = src[2 * i], x1 = src[2 * i + 1];
#pragma unroll
        for (int ks = 1; ks < 16; ++ks) { x0 += src[(size_t)ks * (NSM * DM / 4) + 2 * i]; x1 += src[(size_t)ks * (NSM * DM / 4) + 2 * i + 1]; }
        v4u o; o.x = pk2(x0.x, x0.y); o.y = pk2(x0.z, x0.w); o.z = pk2(x1.x, x1.y); o.w = pk2(x1.z, x1.w); dst[i] = o; }
}

typedef short s4v __attribute__((ext_vector_type(4)));
constexpr int TAB0 = LDSCTL_OFF + 1024, TAB1 = TAB0 + 4096;
static_assert(TAB1 + 4096 <= LDS_BYTES, "LDS tables");
__device__ __forceinline__ unsigned img_off(unsigned row, unsigned ch) { return 256u * row + 16u * (ch ^ (((row & 3u) << 2) | ((row >> 2) & 3u))); }
__device__ __forceinline__ s4v tr_rd(LAS unsigned char* p) { return __builtin_amdgcn_ds_read_tr16_b64_v4i16((LAS s4v*)p); }
__device__ __forceinline__ bf16x8 mk8(s4v a, s4v b) { return (bf16x8){a[0], a[1], a[2], a[3], b[0], b[1], b[2], b[3]}; }
__device__ __forceinline__ float ret_lg2(int hh) { return log2f(1.0f - exp2f(-5.0f - (float)hh)); }
#define MFMA16(a, b, c) __builtin_amdgcn_mfma_f32_16x16x32_bf16((a), (b), (c), 0, 0, 0)

__device__ __forceinline__ unsigned img64_off(unsigned row, unsigned ch) { return 128u * row + 16u * (ch ^ (((row >> 1) & 3u) << 1)); }
__device__ __forceinline__ void dma16(const void* g, LAS unsigned char* l) {
    const unsigned lds_dst = __builtin_amdgcn_readfirstlane((unsigned)(size_t)l); unsigned keep;
    asm volatile("s_mov_b32 %0, m0\n\ts_mov_b32 m0, %2\n\ts_nop 0\n\tglobal_load_lds_dwordx4 %1, off\n\ts_mov_b32 m0, %0" : "=&s"(keep) : "v"(g), "s"(lds_dst) : "memory");
}
template <int NROWS> __device__ __forceinline__ void stage256(const bf16* src, size_t ld, LAS unsigned char* dst, int wave, int lane) {
#pragma unroll
    for (int i0 = 0; i0 < NROWS / 4; i0 += 8) { const int i = i0 + wave, row = 4 * i + (lane >> 4), cs = lane & 15, ch = cs ^ (((row & 3) << 2) | ((row >> 2) & 3));
        dma16(src + (size_t)row * ld + ch * 8, dst + i * 1024); }
}
template <int NROWS> __device__ __forceinline__ void stage128(const bf16* src, size_t ld, LAS unsigned char* dst, int wave, int lane) {
#pragma unroll
    for (int i0 = 0; i0 < NROWS / 8; i0 += 8) { const int i = i0 + wave, row = 8 * i + (lane >> 3), cs = lane & 7, ch = cs ^ (((row >> 1) & 3) << 1);
        dma16(src + (size_t)row * ld + ch * 8, dst + i * 1024); }
}
struct PCtx { unsigned char* ws; const float* dskip; const float* snw; };
template <bool RET> __device__ __forceinline__ void passC_unit(const PCtx a, LAS unsigned char* lds, int b, int c, int gi, int tid, int wave, int lane) {
    constexpr int N = RET ? 256 : 128, NKI = N / 128, NKS = N / 32;
    constexpr int BUFSZ = 49152, K_OFF = RET ? 49152 : 114688, S_OFF = RET ? 16384 : 32768, Z_OFF = 16384;
    const size_t R0 = (size_t)b * SEQ + (size_t)c * 128;
    const bf16* PROJ = (const bf16*)(a.ws + WS_PROJ); const bf16* XBCA = (const bf16*)(a.ws + WS_XBCA);
    const float* DTV = (const float*)(a.ws + WS_DTV); const float* ACS = (const float*)(a.ws + WS_ACS);
    constexpr size_t ld = 128;
    const bf16* Ksrc = RET ? PROJ + toff((int)R0, C_K + gi * 256, NCT_P) : XBCA + toff((int)R0, INNER + gi * 128, NCT_X);
    const bf16* Qsrc = RET ? PROJ + toff((int)R0, C_Q + gi * 256, NCT_P) : XBCA + toff((int)R0, INNER + NG * NST + gi * 128, NCT_X);
    const bf16* Xsrc = RET ? PROJ + toff((int)R0, C_V + gi * 512, NCT_P) : XBCA + toff((int)R0, gi * 512, NCT_X);
    const bf16* Zsrc = PROJ + toff((int)R0, C_Z + gi * 512, NCT_P);
    const bf16* SP = (const bf16*)(a.ws + (RET ? WS_SPR : WS_SPS)) + (size_t)((b * 16 + c) * 8 + gi) * 8 * 64 * N;
    bf16* Yout = (bf16*)(a.ws + (RET ? WS_YR : WS_YS)) + R0 * INNER + gi * 512;
    LAS float* TA = (LAS float*)(lds + TAB0); LAS float* TD = (LAS float*)(lds + TAB1);
    const int g4 = lane >> 4, l15 = lane & 15, q4 = l15 >> 2, p4 = lane & 3, L0 = 16 * wave, lrow = L0 + l15;
    const int ps = (p4 == 1) ? 2 : (p4 == 2 ? 1 : p4), gs = (g4 == 1) ? 2 : (g4 == 2 ? 1 : g4), l15s = 4 * ((q4 == 1) ? 2 : (q4 == 2 ? 1 : q4)) + (l15 & 3);
    const bool up = lane >= 32; const int nst = up ? ((g4 == 3) ? 8 : 0) : 4 * gs;
    const float lg2 = RET ? ret_lg2(gi) : 0.f;
#define STAGE_R(r_) do { LAS unsigned char* bb_ = lds + ((r_) % 3) * BUFSZ; \
        stage128<128>(Xsrc + ((r_) >> 1) * 16384 + ((r_) & 1) * 64, ld, bb_, wave, lane); \
        if (!RET) stage128<128>(Zsrc + ((r_) >> 1) * 16384 + ((r_) & 1) * 64, ld, bb_ + Z_OFF, wave, lane); \
        _Pragma("unroll") for (int h_ = 0; h_ < NKI; ++h_) stage256<64>(SP + (size_t)(r_) * 64 * N + h_ * 128, (size_t)N, bb_ + S_OFF + h_ * 16384, wave, lane); } while (0)
    __syncthreads();
#pragma unroll
    for (int h = 0; h < NKI; ++h) stage256<128>(Ksrc + h * 16384, ld, lds + K_OFF + h * 32768, wave, lane);
    STAGE_R(0);
    if (!RET) STAGE_R(1);
    if (!RET) for (int i = tid; i < 1024; i += 512) { const int r = i >> 7, s = i & 127; TA[i] = ACS[(R0 + s) * NH + gi * 8 + r]; TD[i] = DTV[(R0 + s) * NH + gi * 8 + r]; }
    bf16x8 qf[NKS];
#pragma unroll
    for (int ks = 0; ks < NKS; ++ks) qf[ks] = *(const bf16x8*)(Qsrc + (ks >> 2) * 16384 + (size_t)lrow * ld + 32 * (ks & 3) + 8 * g4);
    asm volatile("s_waitcnt vmcnt(0)" ::: "memory");
    __syncthreads();
    f32x4 gt[8];
#pragma unroll
    for (int si = 0; si < 8; ++si) { gt[si] = (f32x4){0.f, 0.f, 0.f, 0.f};
        if (si <= wave) {
#pragma unroll
            for (int ks = 0; ks < NKS; ++ks) { const bf16x8 ka = *(const LAS bf16x8*)(lds + K_OFF + (ks >> 2) * 32768 + img_off(16 * si + l15, 4 * (ks & 3) + g4)); gt[si] = MFMA16(ka, qf[ks], gt[si]); }
            asm volatile("" ::: "memory"); } }
    bf16x8 mt[4];
    if (RET) {
#pragma unroll
        for (int kp = 0; kp < 4; ++kp) { float v[8];
#pragma unroll
            for (int t = 0; t < 2; ++t)
#pragma unroll
                for (int i = 0; i < 4; ++i) { const int s = 32 * kp + 16 * t + 4 * g4 + i; v[4 * t + i] = (s <= lrow) ? gt[2 * kp + t][i] * exp2f(lg2 * (float)(lrow - s)) : 0.f; }
            const unsigned w0 = pk2(v[0], v[1]), w1 = pk2(v[2], v[3]), w2 = pk2(v[4], v[5]), w3 = pk2(v[6], v[7]);
            mt[kp] = __builtin_bit_cast(bf16x8, (v4u){w0, w1, w2, w3}); }
    }
    float ssq = 0.f;
    __syncthreads();
    if (RET) STAGE_R(1);
#pragma unroll 1
    for (int r = 0; r < 8; ++r) {
        if (r < 6) STAGE_R(r + 2);
        LAS unsigned char* bb = lds + (r % 3) * BUFSZ;
        float el;
        if (RET) el = exp2f(lg2 * (float)(lrow + 1));
        else { const float al = TA[r * 128 + lrow]; el = __expf(al);
#pragma unroll
            for (int kp = 0; kp < 4; ++kp) if (2 * kp <= wave) { float v[8];
#pragma unroll
                for (int t = 0; t < 2; ++t) { const int s0 = 32 * kp + 16 * t + 4 * g4; const f32x4 as = *(const LAS f32x4*)(TA + r * 128 + s0), ds = *(const LAS f32x4*)(TD + r * 128 + s0);
#pragma unroll
                    for (int i = 0; i < 4; ++i) v[4 * t + i] = (s0 + i <= lrow) ? gt[2 * kp + t][i] * __expf(al - as[i]) * ds[i] : 0.f; }
                const unsigned w0 = pk2(v[0], v[1]), w1 = pk2(v[2], v[3]), w2 = pk2(v[4], v[5]), w3 = pk2(v[6], v[7]);
                mt[kp] = __builtin_bit_cast(bf16x8, (v4u){w0, w1, w2, w3}); } }
        const float Dh = RET ? 0.f : a.dskip[gi * 8 + r];
        v2u yp[2];
#pragma unroll 1
        for (int pp2 = 0; pp2 < 2; ++pp2)
#pragma unroll
        for (int ph = 0; ph < 2; ++ph) { const int pt = 2 * pp2 + ph;
            f32x4 ai = (f32x4){0.f, 0.f, 0.f, 0.f}, ae = (f32x4){0.f, 0.f, 0.f, 0.f};
            LAS unsigned char* xb = bb + 8 * (ps & 1);
#pragma unroll
            for (int kp = 0; kp < 4; ++kp) if (2 * kp <= wave) {
                const s4v lo = tr_rd(xb + img64_off(32 * kp + 4 * g4 + q4, 2 * pt + (ps >> 1))), hi = tr_rd(xb + img64_off(32 * kp + 16 + 4 * g4 + q4, 2 * pt + (ps >> 1)));
                ai = MFMA16(mk8(lo, hi), mt[kp], ai); }
#pragma unroll
            for (int ks = 0; ks < NKS; ++ks) { const bf16x8 sa = *(const LAS bf16x8*)(bb + S_OFF + (ks >> 2) * 16384 + img_off(16 * pt + l15s, 4 * (ks & 3) + g4)); ae = MFMA16(sa, qf[ks], ae); }
            float y[4];
#pragma unroll
            for (int i = 0; i < 4; ++i) y[i] = ai[i] + el * ae[i];
            if (!RET) {
                const unsigned xo = img64_off(lrow, 2 * pt + (gs >> 1)) + 8 * (gs & 1);
                const v2u xw = *(const LAS v2u*)(bb + xo), zw = *(const LAS v2u*)(bb + Z_OFF + xo);
                y[0] = (y[0] + Dh * bflo(xw.x)) * siluf(bflo(zw.x)); y[1] = (y[1] + Dh * bfhi(xw.x)) * siluf(bfhi(zw.x));
                y[2] = (y[2] + Dh * bflo(xw.y)) * siluf(bflo(zw.y)); y[3] = (y[3] + Dh * bfhi(xw.y)) * siluf(bfhi(zw.y));
            }
            ssq += (y[0] * y[0] + y[1] * y[1]) + (y[2] * y[2] + y[3] * y[3]);
            yp[ph].x = pk2(y[0], y[1]); yp[ph].y = pk2(y[2], y[3]);
            if (ph) {
                const unsigned sx = up ? yp[0].x : yp[1].x, sy = up ? yp[0].y : yp[1].y; const unsigned rx = (unsigned)__shfl_xor((int)sx, 32), ry = (unsigned)__shfl_xor((int)sy, 32);
                const v4u w = up ? (v4u){rx, ry, yp[1].x, yp[1].y} : (v4u){yp[0].x, yp[0].y, rx, ry};
                *(v4u*)(Yout + (size_t)lrow * INNER + r * 64 + 16 * (pt - 1 + (up ? 1 : 0)) + nst) = w; }
        }
        if (r < 6) asm volatile("s_waitcnt vmcnt(8)" ::: "memory"); else asm volatile("s_waitcnt vmcnt(0)" ::: "memory");
        __builtin_amdgcn_s_barrier();
        asm volatile("" ::: "memory");
    }
#undef STAGE_R
    ssq += __shfl_xor(ssq, 16); ssq += __shfl_xor(ssq, 32);
    const float rstd = 1.0f / sqrtf(ssq * (1.0f / 512.0f) + EPS);
#pragma unroll 1
    for (int hb = 0; hb < 2; ++hb) {
        v4u yw[8], gw[8];
#pragma unroll
        for (int j = 0; j < 8; ++j) { const int col = (hb * 4 + (j >> 1)) * 64 + 16 * (2 * (j & 1) + (up ? 1 : 0)) + nst;
            yw[j] = *(const v4u*)(Yout + (size_t)lrow * INNER + col);
            if (RET) gw[j] = *(const v4u*)(PROJ + toff((int)R0 + lrow, C_G + gi * 512 + col, NCT_P)); }
#pragma unroll
        for (int j = 0; j < 8; ++j) { const int col = (hb * 4 + (j >> 1)) * 64 + 16 * (2 * (j & 1) + (up ? 1 : 0)) + nst;
            float o[8] = {bflo(yw[j].x) * rstd, bfhi(yw[j].x) * rstd, bflo(yw[j].y) * rstd, bfhi(yw[j].y) * rstd, bflo(yw[j].z) * rstd, bfhi(yw[j].z) * rstd, bflo(yw[j].w) * rstd, bfhi(yw[j].w) * rstd};
            if (RET) { o[0] *= siluf(bflo(gw[j].x)); o[1] *= siluf(bfhi(gw[j].x)); o[2] *= siluf(bflo(gw[j].y)); o[3] *= siluf(bfhi(gw[j].y)); o[4] *= siluf(bflo(gw[j].z)); o[5] *= siluf(bfhi(gw[j].z)); o[6] *= siluf(bflo(gw[j].w)); o[7] *= siluf(bfhi(gw[j].w)); }
            else { const f32x4 n0 = *(const f32x4*)(a.snw + gi * 512 + col), n1 = *(const f32x4*)(a.snw + gi * 512 + col + 4); o[0] *= n0.x; o[1] *= n0.y; o[2] *= n0.z; o[3] *= n0.w; o[4] *= n1.x; o[5] *= n1.y; o[6] *= n1.z; o[7] *= n1.w; }
            v4u ov; ov.x = pk2(o[0], o[1]); ov.y = pk2(o[2], o[3]); ov.z = pk2(o[4], o[5]); ov.w = pk2(o[6], o[7]); *(v4u*)(Yout + (size_t)lrow * INNER + col) = ov; }
    }
}

__device__ __forceinline__ void passC(unsigned char* ws, const float* dskip, const float* snw, LAS unsigned char* lds) {
    const PCtx a{ws, dskip, snw}; const int tid = threadIdx.x, lane = tid & 63, wave = __builtin_amdgcn_readfirstlane(tid >> 6);
#if !defined(ONLY_SSD)
    for (int u = blockIdx.x; u < 512; u += gridDim.x) passC_unit<true>(a, lds, u >> 7, (u >> 3) & 15, u & 7, tid, wave, lane);
#endif
#if !defined(ONLY_RET)
    for (int u = blockIdx.x; u < 512; u += gridDim.x) passC_unit<false>(a, lds, u >> 7, (u >> 3) & 15, u & 7, tid, wave, lane);
#endif
}

template <bool RET> __device__ __forceinline__ void scan_unit(const Args& a, LAS unsigned char* lds, int b, int gi, int rp, int nh, int tid, int wave, int lane) {
    constexpr int N = RET ? 256 : 128;
    const bf16* PROJ = (const bf16*)(a.ws + WS_PROJ); const bf16* XBCA = (const bf16*)(a.ws + WS_XBCA);
    const float* DTV = (const float*)(a.ws + WS_DTV); const float* ACS = (const float*)(a.ws + WS_ACS);
    constexpr size_t ld = 128, CSTEP = (size_t)(RET ? NCT_P : NCT_X) * 16384;
    const size_t Rb = (size_t)b * SEQ;
    const bf16* Ksrc = RET ? PROJ + toff((int)Rb, C_K + gi * 256 + nh * 128, NCT_P) : XBCA + toff((int)Rb, INNER + gi * 128, NCT_X);
    const bf16* Xsrc = RET ? PROJ + toff((int)Rb, C_V + gi * 512 + rp * 128, NCT_P) : XBCA + toff((int)Rb, gi * 512 + rp * 128, NCT_X);
    bf16* SP = (bf16*)(a.ws + (RET ? WS_SPR : WS_SPS));
    LAS float* TBL = (LAS float*)(lds + 131072);
    const int g4 = lane >> 4, l15 = lane & 15, q4 = l15 >> 2, p4 = lane & 3;
    const int ps = (p4 == 1) ? 2 : (p4 == 2 ? 1 : p4), gs = (g4 == 1) ? 2 : (g4 == 2 ? 1 : g4);
    const bool up = lane >= 32; const int nst = up ? ((g4 == 3) ? 8 : 0) : 4 * gs;
    const float lg2 = RET ? ret_lg2(gi) : 0.f;
    float wb[4], wj[8]; const float decR = RET ? exp2f(lg2 * 128.f) : 0.f;
#pragma unroll
    for (int ks = 0; ks < 4; ++ks) wb[ks] = RET ? exp2f(lg2 * (float)(127 - (32 * ks + 8 * g4))) : 0.f;
#pragma unroll
    for (int j = 0; j < 8; ++j) wj[j] = RET ? exp2f(-lg2 * (float)j) : 0.f;
#define SC_STAGE_K(c_) stage256<128>(Ksrc + (size_t)(c_) * CSTEP, ld, lds + ((2 * (c_)) & 3) * 32768, wave, lane)
#define SC_STAGE_X(c_) stage256<128>(Xsrc + (size_t)(c_) * CSTEP, ld, lds + ((2 * (c_) + 1) & 3) * 32768, wave, lane)
#define SC_TBLVAL(c_, dst) do { if (!RET && tid < 258) { const int rr_ = tid < 256 ? (tid >> 7) : (tid - 256), s_ = tid < 256 ? (tid & 127) : 127; const int h_ = gi * 8 + 2 * rp + rr_; \
            const size_t r0_ = Rb + (size_t)(c_) * 128; const float aend_ = ACS[(r0_ + 127) * NH + h_]; \
            dst = tid < 256 ? DTV[(r0_ + s_) * NH + h_] * __expf(aend_ - ACS[(r0_ + s_) * NH + h_]) : __expf(aend_); } } while (0)
    f32x4 acc[2][4];
#pragma unroll
    for (int rr = 0; rr < 2; ++rr)
#pragma unroll
        for (int pt = 0; pt < 4; ++pt) acc[rr][pt] = (f32x4){0.f, 0.f, 0.f, 0.f};
    __syncthreads();
    SC_STAGE_K(0); SC_STAGE_X(0); SC_STAGE_K(1);
    { float tv = 0.f; SC_TBLVAL(0, tv); if (!RET && tid < 258) TBL[tid] = tv; }
    asm volatile("s_waitcnt vmcnt(0)" ::: "memory");
    __syncthreads();
#pragma unroll 1
    for (int c = 0; c < 16; ++c) {
        if (c < 15) SC_STAGE_X(c + 1);
        bf16x8 kf[4];
        { LAS unsigned char* kb = lds + ((2 * c) & 3) * 32768 + 8 * (ps & 1);
#pragma unroll
          for (int ks = 0; ks < 4; ++ks) { const s4v lo = tr_rd(kb + img_off(32 * ks + 8 * g4 + q4, 2 * wave + (ps >> 1))), hi = tr_rd(kb + img_off(32 * ks + 8 * g4 + 4 + q4, 2 * wave + (ps >> 1)));
            kf[ks] = mk8(lo, hi); } }
        asm volatile("s_waitcnt lgkmcnt(0)" ::: "memory");
        if (c < 15) asm volatile("s_waitcnt vmcnt(12)" ::: "memory"); else asm volatile("s_waitcnt vmcnt(0)" ::: "memory");
        __builtin_amdgcn_s_barrier(); asm volatile("" ::: "memory");
        float tvn = 0.f; if (c < 15) SC_TBLVAL(c + 1, tvn);
        { bf16* sp = SP + ((size_t)((b * 16 + c) * 8 + gi) * 8 + 2 * rp) * 64 * N + (RET ? nh * 128 : 0) + 16 * wave + nst;
#pragma unroll
          for (int rr = 0; rr < 2; ++rr)
#pragma unroll
            for (int pp = 0; pp < 2; ++pp) {
                v2u oe, oo; oe.x = pk2(acc[rr][2 * pp][0], acc[rr][2 * pp][1]); oe.y = pk2(acc[rr][2 * pp][2], acc[rr][2 * pp][3]);
                oo.x = pk2(acc[rr][2 * pp + 1][0], acc[rr][2 * pp + 1][1]); oo.y = pk2(acc[rr][2 * pp + 1][2], acc[rr][2 * pp + 1][3]);
                const unsigned sx = up ? oe.x : oo.x, sy = up ? oe.y : oo.y; const unsigned rx = (unsigned)__shfl_xor((int)sx, 32), ry = (unsigned)__shfl_xor((int)sy, 32);
                const v4u w = up ? (v4u){rx, ry, oo.x, oo.y} : (v4u){oe.x, oe.y, rx, ry};
                *(v4u*)(sp + (size_t)(rr * 64 + 16 * (2 * pp + (up ? 1 : 0)) + l15) * N) = w; } }
        if (c < 14) SC_STAGE_K(c + 2);
        LAS unsigned char* xb0 = lds + ((2 * c + 1) & 3) * 32768; LAS float* T = TBL + (c & 1) * 512;
#pragma unroll
        for (int rr = 0; rr < 2; ++rr) {
            const float dec = RET ? decR : T[256 + rr];
            bf16x8 kw[4];
#pragma unroll
            for (int ks = 0; ks < 4; ++ks) { float w[8];
                if (RET) {
#pragma unroll
                    for (int j = 0; j < 8; ++j) w[j] = wb[ks] * wj[j];
                } else { const f32x4 w0 = *(const LAS f32x4*)(T + rr * 128 + 32 * ks + 8 * g4), w1 = *(const LAS f32x4*)(T + rr * 128 + 32 * ks + 8 * g4 + 4);
                    w[0] = w0.x; w[1] = w0.y; w[2] = w0.z; w[3] = w0.w; w[4] = w1.x; w[5] = w1.y; w[6] = w1.z; w[7] = w1.w; }
                const v4u kv = __builtin_bit_cast(v4u, kf[ks]);
                kw[ks] = __builtin_bit_cast(bf16x8, (v4u){pk2(bflo(kv.x) * w[0], bfhi(kv.x) * w[1]), pk2(bflo(kv.y) * w[2], bfhi(kv.y) * w[3]), pk2(bflo(kv.z) * w[4], bfhi(kv.z) * w[5]), pk2(bflo(kv.w) * w[6], bfhi(kv.w) * w[7])}); }
#pragma unroll
            for (int pt = 0; pt < 4; ++pt) {
                f32x4 d = acc[rr][pt] * dec;
                LAS unsigned char* base = xb0 + 8 * (p4 & 1); const int cc = rr * 4 + pt;
#pragma unroll
                for (int ks = 0; ks < 4; ++ks) {
                    const s4v lo = tr_rd(base + img_off(32 * ks + 8 * g4 + q4, 2 * cc + (p4 >> 1))), hi = tr_rd(base + img_off(32 * ks + 8 * g4 + 4 + q4, 2 * cc + (p4 >> 1)));
                    d = MFMA16(kw[ks], mk8(lo, hi), d); }
                acc[rr][pt] = d; if (pt & 1) asm volatile("" ::: "memory"); }
        }
        if (!RET && c < 15 && tid < 258) TBL[((c + 1) & 1) * 512 + tid] = tvn;
        if (c < 14) asm volatile("s_waitcnt vmcnt(12)" ::: "memory"); else asm volatile("s_waitcnt vmcnt(0)" ::: "memory");
        asm volatile("s_waitcnt lgkmcnt(0)" ::: "memory");
        __builtin_amdgcn_s_barrier(); asm volatile("" ::: "memory");
    }
#undef SC_STAGE_K
#undef SC_STAGE_X
#undef SC_TBLVAL
    float* so = a.out + (RET ? O_RETP + ((size_t)(b * RH + gi) * RDV + rp * 128) * RDK + nh * 128 : O_SSMP + ((size_t)(b * NH + gi * 8 + 2 * rp) * 64) * NST) + 16 * wave + 4 * gs;
#pragma unroll
    for (int rr = 0; rr < 2; ++rr)
#pragma unroll
        for (int pt = 0; pt < 4; ++pt) *(f32x4*)(so + (size_t)(rr * 64 + 16 * pt + l15) * N) = acc[rr][pt];
}
__device__ __forceinline__ void scan_phase(const Args& a, LAS unsigned char* lds, int tid, int wave, int lane) {
    const int G = gridDim.x, vcu = (G % 8 == 0) ? (int)(blockIdx.x % 8) * (G / 8) + (int)(blockIdx.x / 8) : (int)blockIdx.x;
    for (int u = vcu; u < 256; u += G) scan_unit<true>(a, lds, u >> 6, (u >> 3) & 7, (u >> 1) & 3, u & 1, tid, wave, lane);
    for (int u = (vcu + 128) % G; u < 128; u += G) scan_unit<false>(a, lds, u >> 5, (u >> 2) & 7, u & 3, 0, tid, wave, lane);
}

template <bool RET> __device__ __forceinline__ void samp_stream(const Args& a, LAS unsigned char* lds, int tid, int wave, int lane, const int u0, const int ustride, const int nu) {
    constexpr int N = RET ? 256 : 128, NKS = N / 32, NSUB = N / 128, NTC = 2;
    constexpr int TSET = 28672;
    const bf16* PROJ = (const bf16*)(a.ws + WS_PROJ); const bf16* XBCA = (const bf16*)(a.ws + WS_XBCA);
    const float* DTV = (const float*)(a.ws + WS_DTV); const float* LA = (const float*)(a.ws + WS_LA);
    const bf16* Kb_ = RET ? PROJ : XBCA; const int nct = RET ? NCT_P : NCT_X;
    LAS float* SQ = (LAS float*)(lds + 2 * TSET); LAS float* YL = (LAS float*)(lds + 2 * TSET + 1024);
    const int g4 = lane >> 4, l15 = lane & 15, tt = l15 & 3;
    f32x4 cur[8], nxt[8];
    v4u tr[NTC]; float wv = 0.f;
#define TLOAD(bs_, gi_) do { const int Rs_ = NPR + (bs_) * SL; \
        _Pragma("unroll") for (int q_ = 0; q_ < NTC; ++q_) { const int k_ = tid + 512 * q_; int t_, col_; const bf16* src_ = Kb_; int nc_ = nct; \
            if (RET) { if (k_ < 128) { t_ = k_ >> 5; col_ = C_K + (gi_) * 256 + (k_ & 31) * 8; } else if (k_ < 256) { t_ = (k_ - 128) >> 5; col_ = C_Q + (gi_) * 256 + (k_ & 31) * 8; } else if (k_ < 512) { t_ = (k_ - 256) >> 6; col_ = C_V + (gi_) * 512 + (k_ & 63) * 8; } else { const int kk_ = k_ < 768 ? k_ - 512 : 0; t_ = kk_ >> 6; col_ = C_G + (gi_) * 512 + (kk_ & 63) * 8; } } \
            else { if (k_ < 64) { t_ = k_ >> 4; col_ = INNER + (gi_) * 128 + (k_ & 15) * 8; } else if (k_ < 128) { t_ = (k_ - 64) >> 4; col_ = INNER + NG * NST + (gi_) * 128 + (k_ & 15) * 8; } \
                   else if (k_ < 384) { t_ = (k_ - 128) >> 6; col_ = (gi_) * 512 + ((k_ - 128) & 63) * 8; } else { const int kk_ = k_ < 640 ? k_ - 384 : 0; t_ = kk_ >> 6; col_ = C_Z + (gi_) * 512 + (kk_ & 63) * 8; src_ = PROJ; nc_ = NCT_P; } } \
            tr[q_] = *(const v4u*)(src_ + toff(Rs_ + t_, col_, nc_)); } \
        if (lane < 8) { if (RET) wv = lane < 4 ? (float)(lane + 1) * logf(1.0f - exp2f(-5.0f - (float)(gi_))) : 1.0f; \
            else { const int h_ = (gi_) * 8 + wave; if (lane < 4) { wv = 0.f; for (int t2 = 0; t2 <= lane; ++t2) wv += LA[(size_t)(Rs_ + t2) * NH + h_]; } else wv = DTV[(size_t)(Rs_ + lane - 4) * NH + h_]; } } } while (0)
#define TWRITE(ts_) do { LAS unsigned char* tb_ = lds + (ts_) * TSET; \
        _Pragma("unroll") for (int q_ = 0; q_ < NTC; ++q_) { const int k_ = tid + 512 * q_; int off_ = -1; \
            if (RET) { if (k_ < 128) off_ = k_ * 32; else if (k_ < 256) off_ = 4096 + (k_ - 128) * 32; else if (k_ < 512) off_ = 8192 + (k_ - 256) * 32; else if (k_ < 768) off_ = 16384 + (k_ - 512) * 32; } \
            else { if (k_ < 64) off_ = k_ * 32; else if (k_ < 128) off_ = 4096 + (k_ - 64) * 32; else if (k_ < 384) off_ = 8192 + (k_ - 128) * 32; else if (k_ < 640) off_ = 16384 + (k_ - 384) * 32; } \
            if (off_ >= 0) { const v4u v_ = tr[q_]; *(LAS f32x4*)(tb_ + off_) = (f32x4){bflo(v_.x), bfhi(v_.x), bflo(v_.y), bfhi(v_.y)}; *(LAS f32x4*)(tb_ + off_ + 16) = (f32x4){bflo(v_.z), bfhi(v_.z), bflo(v_.w), bfhi(v_.w)}; } } \
        if (lane < 8) ((LAS float*)(tb_ + 24832))[wave * 8 + lane] = wv; } while (0)
#define SIN_OF(bs_, gi_) ((RET ? a.in[I_SRET] : a.in[I_SSSM]) + (RET ? ((size_t)((bs_) * RH + (gi_)) * RDV + wave * 64) : ((size_t)((bs_) * NH + (gi_) * 8 + wave) * 64)) * N)
#define SLOAD(dst, Sin_, j) do { const float* sp_ = (Sin_) + (size_t)(((j) / NSUB) * 16 + l15) * N + ((j) % NSUB) * 128 + 4 * g4; \
        _Pragma("unroll") for (int k_ = 0; k_ < 4; ++k_) { dst[2 * k_] = *(const f32x4*)(sp_ + 32 * k_); dst[2 * k_ + 1] = *(const f32x4*)(sp_ + 32 * k_ + 16); } } while (0)
    if (nu == 0) return;
    __syncthreads();
    { TLOAD(u0 >> 3, u0 & 7); TWRITE(0); SLOAD(cur, SIN_OF(u0 >> 3, u0 & 7), 0); }
    __syncthreads();
#pragma unroll 1
    for (int i = 0; i < nu; ++i) {
        const int u = u0 + i * ustride, bs = u >> 3, gi = u & 7, un = u + ustride, bsn = un >> 3, gin = un & 7; const bool more = i + 1 < nu;
        const size_t Rs = (size_t)NPR + (size_t)bs * SL;
        LAS unsigned char* tb = lds + (i & 1) * TSET;
        LAS float* BT = (LAS float*)tb; LAS float* CR = (LAS float*)(tb + 4096); LAS float* XT = (LAS float*)(tb + 8192); LAS float* ZT = (LAS float*)(tb + 16384);
        LAS float* CB = (LAS float*)(tb + 24576); LAS float* WSC = (LAS float*)(tb + 24832);
        const float* Sin = SIN_OF(bs, gi); float* Sout = a.out + (RET ? O_RETS : O_SSMS) + (Sin - (RET ? a.in[I_SRET] : a.in[I_SSSM]));
        for (int pp = wave; pp < 16; pp += 8) { const int t = pp >> 2, s = pp & 3; float d = 0.f; for (int n = lane; n < N; n += 64) d += CR[t * N + n] * BT[s * N + n]; d = wave_sum(d); if (lane == 0) CB[pp] = d; }
        __syncthreads();
        if (more) TLOAD(bsn, gin);
        const float acs_t = WSC[wave * 8 + tt], acs3 = WSC[wave * 8 + 3], A3 = __expf(acs3), At = __expf(acs_t);
        float cf[4], wd[4];
#pragma unroll
        for (int s = 0; s < 4; ++s) { const float as = WSC[wave * 8 + s], ds = WSC[wave * 8 + 4 + s]; cf[s] = (s <= tt) ? __expf(acs_t - as) * ds * CB[tt * 4 + s] : 0.f; wd[s] = __expf(acs3 - as) * ds; }
        const float Dh = RET ? 0.f : a.in[I_DSKIP][gi * 8 + wave];
        bf16x8 qf[NKS];
#pragma unroll
        for (int ks = 0; ks < NKS; ++ks) { const f32x4 c0 = *(const LAS f32x4*)(CR + tt * N + 32 * ks + 4 * g4), c1 = *(const LAS f32x4*)(CR + tt * N + 32 * ks + 16 + 4 * g4);
            const float m = l15 < 4 ? At : 0.f;
            qf[ks] = __builtin_bit_cast(bf16x8, (v4u){pk2(c0.x * m, c0.y * m), pk2(c0.z * m, c0.w * m), pk2(c1.x * m, c1.y * m), pk2(c1.z * m, c1.w * m)}); }
        float ssq = 0.f; f32x4 acc = (f32x4){0.f, 0.f, 0.f, 0.f};
#define SAMP_SUB(st, j) do { const int slab_ = (j) / NSUB, sub_ = (j) % NSUB, pu_ = 64 * wave + 16 * slab_; \
        float u_[4]; _Pragma("unroll") for (int s = 0; s < 4; ++s) u_[s] = wd[s] * XT[s * 512 + pu_ + l15]; \
        float* op_ = Sout + (size_t)(slab_ * 16 + l15) * N + sub_ * 128 + 4 * g4; \
        _Pragma("unroll") for (int k = 0; k < 4; ++k) { \
            const f32x4 s0 = st[2 * k], s1 = st[2 * k + 1]; \
            const bf16x8 af = __builtin_bit_cast(bf16x8, (v4u){pk2(s0.x, s0.y), pk2(s0.z, s0.w), pk2(s1.x, s1.y), pk2(s1.z, s1.w)}); \
            acc = MFMA16(af, (NSUB == 1 || sub_ == 0) ? qf[k] : qf[(NKS - 4) + k], acc); \
            f32x4 n0 = s0 * A3, n1 = s1 * A3; \
            _Pragma("unroll") for (int s = 0; s < 4; ++s) { const f32x4 b0 = *(const LAS f32x4*)(BT + s * N + sub_ * 128 + 32 * k + 4 * g4), b1 = *(const LAS f32x4*)(BT + s * N + sub_ * 128 + 32 * k + 16 + 4 * g4); \
                n0 += b0 * u_[s]; n1 += b1 * u_[s]; } \
            *(f32x4*)(op_ + 32 * k) = n0; *(f32x4*)(op_ + 32 * k + 16) = n1; } \
        if (sub_ == NSUB - 1) { \
            _Pragma("unroll") for (int i = 0; i < 4; ++i) { const int pc = pu_ + 4 * g4 + i; \
                float y = acc[i] + cf[0] * XT[pc] + cf[1] * XT[512 + pc] + cf[2] * XT[1024 + pc] + cf[3] * XT[1536 + pc]; \
                if (!RET) { y += Dh * XT[tt * 512 + pc]; const float z = ZT[tt * 512 + pc]; y *= siluf(z); } \
                if (l15 < 4) { YL[pc * 4 + tt] = y; ssq += y * y; } } \
            acc = (f32x4){0.f, 0.f, 0.f, 0.f}; } } while (0)
#pragma unroll 1
        for (int jp = 0; jp < 2 * NSUB; ++jp) {
            SLOAD(nxt, Sin, 2 * jp + 1);
            SAMP_SUB(cur, 2 * jp);
            if (jp + 1 < 2 * NSUB) SLOAD(cur, Sin, 2 * jp + 2);
            SAMP_SUB(nxt, 2 * jp + 1);
        }
        if (more) { SLOAD(cur, SIN_OF(bsn, gin), 0); TWRITE((i + 1) & 1); }
#undef SAMP_SUB
        ssq += __shfl_xor(ssq, 16); ssq += __shfl_xor(ssq, 32);
        if (lane < 4) SQ[wave * 4 + lane] = ssq;
        __syncthreads();
        float tot = 0.f;
#pragma unroll
        for (int w = 0; w < 8; ++w) tot += SQ[w * 4 + tt];
        const float rstd = 1.0f / sqrtf(tot * (1.0f / 512.0f) + EPS);
        if (l15 < 4) {
            bf16* Yo = (bf16*)(a.ws + (RET ? WS_YR : WS_YS)) + (Rs + tt) * INNER + gi * 512;
#pragma unroll 1
            for (int slab = 0; slab < 4; ++slab) { const int pc = 64 * wave + 16 * slab + 4 * g4; float o[4];
#pragma unroll
                for (int i2 = 0; i2 < 4; ++i2) { o[i2] = YL[(pc + i2) * 4 + tt] * rstd;
                    if (RET) o[i2] *= siluf(ZT[tt * 512 + pc + i2]); else o[i2] *= a.in[I_SNW][gi * 512 + pc + i2]; }
                v2u ov; ov.x = pk2(o[0], o[1]); ov.y = pk2(o[2], o[3]); *(v2u*)(Yo + pc) = ov; }
        }
        __syncthreads();
    }
#undef TLOAD
#undef TWRITE
#undef SIN_OF
#undef SLOAD
}
__device__ __forceinline__ void scan_samp_phase(const Args& a, LAS unsigned char* lds, int tid, int wave, int lane) {
    const int G = gridDim.x;
    scan_phase(a, lds, tid, wave, lane);
    if (G == 256) {
        const int vcu = (int)(blockIdx.x % 8) * 32 + (int)(blockIdx.x / 8);
        samp_stream<true>(a, lds, tid, wave, lane, (int)blockIdx.x, G, 4);
        if (vcu < 128) samp_stream<false>(a, lds, tid, wave, lane, vcu, 128, 5); else samp_stream<false>(a, lds, tid, wave, lane, 640 + (vcu - 128), 128, 3);
    } else {
        const int nu = ((int)blockIdx.x < SB * 8) ? (SB * 8 - 1 - (int)blockIdx.x) / G + 1 : 0;
        samp_stream<true>(a, lds, tid, wave, lane, (int)blockIdx.x, G, nu); samp_stream<false>(a, lds, tid, wave, lane, (int)blockIdx.x, G, nu);
    }
}

#ifndef PROBE_DUP
#define PROBE_DUP 0
#endif
#ifndef MK_N_LAUNCHES
#define MK_N_LAUNCHES 1
#endif
constexpr int N_PHASES = 9;
template <int LO, int HI> __global__ void __launch_bounds__(NWAVES * 64, 2) fwd_kernel(Args args) {
    extern __shared__ __attribute__((aligned(16))) unsigned char lds_raw[];
    LAS unsigned char* lds = (LAS unsigned char*)lds_raw;
    const int tid = threadIdx.x, lane = tid & 63, wave = __builtin_amdgcn_readfirstlane(tid >> 6);
    const int G = gridDim.x;
    for (int u = tid; u < (LDS_BYTES - LDSCTL_OFF) / 4; u += NWAVES * 64) ((LAS unsigned*)(lds + LDSCTL_OFF))[u] = 0u;
    __syncthreads();
    unsigned* ctl = (unsigned*)(args.ws + WS_CTL);
    XcdBarrier bar; bar.bar = ctl + CW_BAR; bar.x = 0; bar.st = nullptr;
    constexpr int lo = LO, hi = HI;
    if (hi - lo > 1) bar = xcd_barrier_post(ctl + CW_BAR, (volatile LAS unsigned*)(lds + MISC_OFF) + 8);
#define IN(k) (lo <= (k) && (k) < hi)
#define IF_IN(k) if constexpr (IN(k))
#define SEAM(k) do { if constexpr (IN(k) && IN((k) + 1)) xcd_barrier(bar); } while (0)

#define PH_0 p0_prologue(args, lds, wave, lane)
#define PH_1 do { pg8::Gemm g{(const bf16*)(args.ws + WS_HN), (const bf16*)(args.ws + WS_WTIN), MT, LDP, DM, nullptr, nullptr}; pg8::StaticOrder S; S.init(MT, LDP, DM, G, (int)blockIdx.x); \
        pg8::EpiProj E{(bf16*)(args.ws + WS_PROJ), (float*)(args.ws + WS_DT), LDP, DT_TILE, (const float*)(args.ws + WS_COS), (const float*)(args.ws + WS_SIN), C_Q / 256, C_K / 256, NPR}; \
        pg8::gemm_phase<pg8::EpiProj, pg8::StaticOrder, true, true>(lds + RING_OFF, g, S, E); } while (0)
#define PH_2 p2_prep(args, lds)
#define PH_3 scan_samp_phase(args, lds, tid, wave, lane)
#define PH_4 passC(args.ws, args.in[I_DSKIP], args.in[I_SNW], lds)
#define PH_5 do { pg8::Gemm g{(const bf16*)(args.ws + WS_YS), (const bf16*)(args.ws + WS_WTPS), MT, DM, INNER, (const bf16*)(args.ws + WS_YR), (const bf16*)(args.ws + WS_WTPR)}; pg8::DualOrder S{G, (int)blockIdx.x}; \
        pg8::EpiDual E{(const bf16*)(args.ws + WS_PROJ), LDP, C_GATE, (bf16*)(args.ws + WS_MG), (float*)(args.ws + WS_MFS), NPR / 256}; \
        pg8::gemm_phase<pg8::EpiDual, pg8::DualOrder, true, true>(lds + RING_OFF, g, S, E); } while (0)
#define PH_6 p7_merge_sample(args)
#define PH_7 do { pg8::Gemm g{(const bf16*)(args.ws + WS_MG), (const bf16*)(args.ws + WS_WTO), MT, DM, DM, nullptr, nullptr}; pg8::OutOrder S{G, (int)blockIdx.x}; \
        pg8::EpiOut2 E{(float*)(args.ws + WS_OF), (float*)(args.ws + WS_OFS), NPR / 256}; \
        pg8::gemm_phase<pg8::EpiOut2, pg8::OutOrder, true, true>(lds + RING_OFF, g, S, E); } while (0)
#define PH_8 p8_final(args, wave, lane)
#ifndef SKIPMASK
#define SKIPMASK 0
#endif
#define RUN(k) do { IF_IN(k) { if constexpr (!(((SKIPMASK) >> (k)) & 1)) PH_##k; if constexpr ((MK_N_LAUNCHES == 1) && (((PROBE_DUP) >> (k)) & 1)) { xcd_barrier(bar); PH_##k; } } SEAM(k); } while (0)
    RUN(0); RUN(1); RUN(2); RUN(3); RUN(4); RUN(5); RUN(6); RUN(7); RUN(8);
#undef RUN
#undef IN
#undef IF_IN
#undef SEAM
}

template <int LO, int HI> static bool setup_one() { return hipFuncSetAttribute((const void*)fwd_kernel<LO, HI>, hipFuncAttributeMaxDynamicSharedMemorySize, LDS_BYTES) == hipSuccess; }
template <int LO, int HI> static void launch_one(int grid, hipStream_t stream, const Args& a) { hipLaunchKernelGGL((fwd_kernel<LO, HI>), dim3(grid), dim3(NWAVES * 64), LDS_BYTES, stream, a); }
#if MK_N_LAUNCHES == 1
static bool setup_all() { return setup_one<0, N_PHASES>(); }
static void launch_all(int grid, hipStream_t stream, const Args& a) { launch_one<0, N_PHASES>(grid, stream, a); }
#else
static bool setup_all() { return setup_one<0, 1>() && setup_one<1, 2>() && setup_one<2, 3>() && setup_one<3, 4>() && setup_one<4, 5>() && setup_one<5, 6>() && setup_one<6, 7>() && setup_one<7, 8>() && setup_one<8, 9>(); }
template <int K> static void launch_ph(int grid, hipStream_t stream, const Args& a) { launch_one<K, K + 1>(grid, stream, a); if ((PROBE_DUP >> K) & 1) launch_one<K, K + 1>(grid, stream, a); }
static void launch_all(int grid, hipStream_t stream, const Args& a) {
    launch_ph<0>(grid, stream, a); launch_ph<1>(grid, stream, a); launch_ph<2>(grid, stream, a); launch_ph<3>(grid, stream, a); launch_ph<4>(grid, stream, a);
    launch_ph<5>(grid, stream, a); launch_ph<6>(grid, stream, a); launch_ph<7>(grid, stream, a); launch_ph<8>(grid, stream, a); }
#endif
extern "C" void kernel_launch(void* const* d_in, const int* in_sizes, int n_in, void* d_out, int out_size, void* d_ws, size_t ws_size, hipStream_t stream) {
    static int grid = 0;
    if (grid == 0) {
        if (n_in != 17 || (size_t)out_size != O_END || ws_size < WS_END) { fprintf(stderr, "kernel_launch: unexpected shapes (n_in %d out %d ws %zu); nothing launched\n", n_in, out_size, ws_size); grid = -1; return; }
        int dev = 0, cus = 0, per_cu = 0;
        if (hipGetDevice(&dev) != hipSuccess || hipDeviceGetAttribute(&cus, hipDeviceAttributeMultiprocessorCount, dev) != hipSuccess) { grid = -1; return; }
        if (!setup_all()) { fprintf(stderr, "kernel_launch: hipFuncSetAttribute failed\n"); grid = -1; return; }
        (void)per_cu; (void)hipGetLastError();
        grid = cus;
    }
    if (grid < 0) return;
    if (hipMemsetAsync((char*)d_ws + WS_CTL, 0, CTL_ZERO_BYTES, stream) != hipSuccess) return;
    Args a{};
    for (int i = 0; i < 17; ++i) a.in[i] = (const float*)d_in[i];
    a.out = (float*)d_out; a.ws = (unsigned char*)d_ws;
    static_assert(sizeof(Args) == 160, "Args has no padding");
    a.ph_lo = 0; a.ph_hi = N_PHASES;
    launch_all(grid, stream, a);
}
#ifdef TEST_LO
template __global__ void fwd_kernel<TEST_LO, TEST_HI>(Args);
#endif
```

```cpp
#include <hip/hip_runtime.h>
#include <cstdio>
#include <cstdint>
namespace pg8 {
#define PG8_LAS __attribute__((address_space(3)))
typedef unsigned short bf16_t;
typedef short bf16x8 __attribute__((ext_vector_type(8)));
typedef float f32x4 __attribute__((ext_vector_type(4)));
typedef unsigned u32x4 __attribute__((ext_vector_type(4)));
constexpr int BM = 256, BK = 64, HALF = 128, HTB = HALF * BK * 2  , STAGE_BYTES = 8 * HTB, NXCD = 8, WGM = 8;

__host__ __device__ __forceinline__ int lds_byte(int r, int c) { const int st = (r >> 4) * 2 + (c >> 5), rr = r & 15, cc = c & 31, ob = rr * 64 + cc * 2; return st * 1024 + (ob ^ (((ob >> 9) & 1) << 5)); }
__host__ __device__ __forceinline__ void stage_rc(int b, int& R, int& C) { const int st = b / 1024, sb = b % 1024, swz = sb ^ (((sb >> 9) & 1) << 5); R = (st >> 1) * 16 + swz / 64; C = (st & 1) * 32 + (swz % 64) / 2; }
__host__ __device__ __forceinline__ int perm32(int rho) { const int n = rho >> 4, i = rho & 15; return 8 * (i >> 2) + 4 * n + (i & 3); }

struct Unit { int pm, pn, sel, k0, nt, mode; };
struct Gemm { const bf16_t* A; const bf16_t* Bt; int M, N, K; const bf16_t* A2; const bf16_t* Bt2; };

struct StaticOrder {
    int nM, nN, nwg, G, c, ntk;
    __host__ __device__ void init(int M, int N, int K, int G_, int c_) { nM = M / BM; nN = N / BM; nwg = nM * nN; G = G_; c = c_; ntk = K / BK; }
    __host__ __device__ bool next(int i, Unit& u) const {
        const long L = (long)i * G + c; if (L >= nwg) return false;
        int wgid = (int)L; { const int q = nwg / NXCD, r = nwg % NXCD, xcd = wgid % NXCD, off = wgid / NXCD; wgid = (xcd < r ? xcd * (q + 1) : r * (q + 1) + (xcd - r) * q) + off; }
        const int nig = WGM * nN, gid = wgid / nig, fm = gid * WGM, gsz = (nM - fm) < WGM ? (nM - fm) : WGM;
        u.pm = fm + ((wgid % nig) % gsz); u.pn = (wgid % nig) / gsz; u.sel = 0; u.k0 = 0; u.nt = ntk; u.mode = 0; return true;
    }
    __device__ __forceinline__ void a_ready(const Unit&) const {}
    __device__ __forceinline__ void done(const Unit&) const {}
};

__device__ __forceinline__ unsigned cvt_pk_bf16(float lo, float hi) { unsigned r; asm volatile("v_cvt_pk_bf16_f32 %0, %1, %2" : "=v"(r) : "v"(lo), "v"(hi)); return r; }
typedef float f32x2 __attribute__((ext_vector_type(2)));

constexpr int PROJ_NCT = 210;
__device__ __forceinline__ size_t toff(int row, int col, int nct) { return ((size_t)(row >> 7) * nct + (col >> 7)) * 16384 + (size_t)(row & 127) * 128 + (col & 127); }
__device__ __forceinline__ float bf_lo(unsigned w) { return __uint_as_float(w << 16); }
__device__ __forceinline__ float bf_hi(unsigned w) { return __uint_as_float(w & 0xffff0000u); }
__device__ __forceinline__ float sigmoidf_(float x) { return __builtin_amdgcn_rcpf(1.0f + __expf(-x)); }

struct EpiProj {
    static constexpr bool PERM = true, AFTER_DRAIN = false, HAS_MID = false;
    bf16_t* O; float* DT; int ldp; int dt_tile; const float* COS; const float* SIN; int qk_tile0, k_tile0, npr;
    __device__ __forceinline__ void operator()(const f32x4 (&acc)[2][2][4][2], const Unit& u, int wr, int wc, int fr, int fq) const {
        asm volatile("" : "+v"(fr), "+v"(fq));
        const int row0 = u.pm * BM + wr * 64 + fr; const unsigned lane_off = (unsigned)(fr * 256 + fq * 16);
        if (u.pn >= qk_tile0 && u.pn < qk_tile0 + 16) {
            const int col0 = u.pn * BM + wc * 32 + 8 * fq, ic = wc * 32 + 8 * fq; const float sc = u.pn >= k_tile0 ? 0.0625f : 1.0f;
#pragma unroll
            for (int ai = 0; ai < 2; ++ai)
#pragma unroll
                for (int m = 0; m < 4; ++m) { const int row = row0 + ai * HALF + m * 16, pidx = row < npr ? (row & 2047) : 2048 + (row & 3);
                    char* tb = (char*)O + (((size_t)(2 * u.pm + ai) * PROJ_NCT + 2 * u.pn) * 16384 + (wr * 64 + m * 16) * 128 + wc * 32) * 2 + lane_off;
                    const f32x4 c0 = *(const f32x4*)(COS + pidx * 128 + ic), c1 = *(const f32x4*)(COS + pidx * 128 + ic + 4), s0 = *(const f32x4*)(SIN + pidx * 128 + ic), s1 = *(const f32x4*)(SIN + pidx * 128 + ic + 4);
                    const f32x4 a0 = acc[ai][0][m][0], a1 = acc[ai][0][m][1], b0 = acc[ai][1][m][0], b1 = acc[ai][1][m][1];
                    const f32x4 o0 = (a0 * c0 - b0 * s0) * sc, o1 = (a1 * c1 - b1 * s1) * sc, p0 = (b0 * c0 + a0 * s0) * sc, p1 = (b1 * c1 + a1 * s1) * sc;
                    u32x4 w; w.x = cvt_pk_bf16(o0[0], o0[1]); w.y = cvt_pk_bf16(o0[2], o0[3]); w.z = cvt_pk_bf16(o1[0], o1[1]); w.w = cvt_pk_bf16(o1[2], o1[3]);
                    *(u32x4*)tb = w;
                    w.x = cvt_pk_bf16(p0[0], p0[1]); w.y = cvt_pk_bf16(p0[2], p0[3]); w.z = cvt_pk_bf16(p1[0], p1[1]); w.w = cvt_pk_bf16(p1[2], p1[3]);
                    *(u32x4*)(tb + 32768) = w;
                    asm volatile("" ::: "memory"); }
        } else if (u.pn != dt_tile) {
            const int col0 = u.pn * BM + wc * 32 + 8 * fq;
#pragma unroll
            for (int ai = 0; ai < 2; ++ai)
#pragma unroll
                for (int m = 0; m < 4; ++m) { char* tb = (char*)O + (((size_t)(2 * u.pm + ai) * PROJ_NCT + 2 * u.pn) * 16384 + (wr * 64 + m * 16) * 128 + wc * 32) * 2 + lane_off;
#pragma unroll
                    for (int bj = 0; bj < 2; ++bj) { const f32x4 v0 = acc[ai][bj][m][0], v1 = acc[ai][bj][m][1];
                        u32x4 w; w.x = cvt_pk_bf16(v0[0], v0[1]); w.y = cvt_pk_bf16(v0[2], v0[3]); w.z = cvt_pk_bf16(v1[0], v1[1]); w.w = cvt_pk_bf16(v1[2], v1[3]);
                        *(u32x4*)(tb + bj * 32768) = w; }
                    asm volatile("" ::: "memory"); }
        } else if (wc < 2) {
#pragma unroll
            for (int ai = 0; ai < 2; ++ai)
#pragma unroll
                for (int m = 0; m < 4; ++m) { float* rp = DT + (size_t)(row0 + ai * HALF + m * 16) * 64 + wc * 32 + 8 * fq;
                    *(f32x4*)rp = acc[ai][0][m][0]; *(f32x4*)(rp + 4) = acc[ai][0][m][1]; }
        }
    }
};
struct EpiDual {
    static constexpr bool PERM = true, AFTER_DRAIN = false, HAS_MID = true;
    const bf16_t* gate; int ldg; int gcol; bf16_t* MG; float* MFS; int prompt_panels; const float* RS;
    __device__ __forceinline__ void pre(float (&pr)[16], const Unit& u, int wr, int fr) const {
        const int row0 = u.pm * BM + wr * 64 + fr, j = u.sel * 8 + (u.k0 >> 9);
#pragma unroll
        for (int ai = 0; ai < 2; ++ai)
#pragma unroll
            for (int m = 0; m < 4; ++m) { const float* rp = RS + (size_t)(row0 + ai * HALF + m * 16) * 16 + j; pr[2 * (ai * 4 + m)] = rp[0]; pr[2 * (ai * 4 + m) + 1] = rp[1]; }
    }
    __device__ __forceinline__ void mid(f32x4 (&acc)[2][2][4][2], const Unit& u, const float (&pr)[16], int wr, int wc, int fr, int fq) const {
        asm volatile("" : "+v"(fr), "+v"(fq));
        const int row0 = u.pm * BM + wr * 64 + fr, col0 = u.pn * BM + wc * 32 + 8 * fq, j = u.sel * 8 + (u.k0 >> 9);
        if (j == 7) {
#pragma unroll
            for (int ai = 0; ai < 2; ++ai)
#pragma unroll
                for (int m = 0; m < 4; ++m) {
#pragma unroll
                    for (int bj = 0; bj < 2; ++bj) { const int c = col0 + bj * HALF;
                        const bf16_t* gp = gate + ((size_t)(2 * u.pm + ai) * PROJ_NCT + ((gcol + c) >> 7)) * 16384 + (wr * 64 + m * 16 + fr) * 128 + wc * 32 + 8 * fq;
                        const u32x4 g1 = *(const u32x4*)gp, g2 = *(const u32x4*)(gp + 16 * 16384);
#define RAT_(a, b) ((1.0f + __expf(-(b))) * __builtin_amdgcn_rcpf(1.0f + __expf(-(a))))
                        f32x4& v0 = acc[ai][bj][m][0]; f32x4& v1 = acc[ai][bj][m][1];
                        v0[0] *= RAT_(bf_lo(g1.x), bf_lo(g2.x)); v0[1] *= RAT_(bf_hi(g1.x), bf_hi(g2.x)); v0[2] *= RAT_(bf_lo(g1.y), bf_lo(g2.y)); v0[3] *= RAT_(bf_hi(g1.y), bf_hi(g2.y));
                        v1[0] *= RAT_(bf_lo(g1.z), bf_lo(g2.z)); v1[1] *= RAT_(bf_hi(g1.z), bf_hi(g2.z)); v1[2] *= RAT_(bf_lo(g1.w), bf_lo(g2.w)); v1[3] *= RAT_(bf_hi(g1.w), bf_hi(g2.w));
#undef RAT_
                    }
                    asm volatile("" ::: "memory"); }
        }
#pragma unroll
        for (int ai = 0; ai < 2; ++ai)
#pragma unroll
            for (int m = 0; m < 4; ++m) { const float rr = pr[2 * (ai * 4 + m)] * __builtin_amdgcn_rcpf(pr[2 * (ai * 4 + m) + 1]);
#pragma unroll
                for (int bj = 0; bj < 2; ++bj) { acc[ai][bj][m][0] *= rr; acc[ai][bj][m][1] *= rr; } }
        (void)row0;
    }
    __device__ __forceinline__ void operator()(const f32x4 (&acc)[2][2][4][2], const Unit& u, int wr, int wc, int fr, int fq) const {
        asm volatile("" : "+v"(fr), "+v"(fq));
        const int row0 = u.pm * BM + wr * 64 + fr, col0 = u.pn * BM + wc * 32 + 8 * fq;
        const bool prompt = u.pm < prompt_panels; const int gc = gcol + ((prompt || u.sel) ? 2048 : 0);
#pragma unroll
        for (int ai = 0; ai < 2; ++ai)
#pragma unroll
            for (int m = 0; m < 4; ++m) { const size_t r = (size_t)(row0 + ai * HALF + m * 16);
#pragma unroll
                for (int bj = 0; bj < 2; ++bj) { const int c = col0 + bj * HALF;
                    const u32x4 gw = *(const u32x4*)(gate + ((size_t)(2 * u.pm + ai) * PROJ_NCT + ((gc + c) >> 7)) * 16384 + (wr * 64 + m * 16 + fr) * 128 + wc * 32 + 8 * fq);
                    const float rl = prompt ? RS[r * 16 + 15] : 1.0f;
                    const f32x4 v0 = acc[ai][bj][m][0] * rl, v1 = acc[ai][bj][m][1] * rl;
                    f32x4 o0, o1;
                    o0[0] = v0[0] * sigmoidf_(bf_lo(gw.x)); o0[1] = v0[1] * sigmoidf_(bf_hi(gw.x)); o0[2] = v0[2] * sigmoidf_(bf_lo(gw.y)); o0[3] = v0[3] * sigmoidf_(bf_hi(gw.y));
                    o1[0] = v1[0] * sigmoidf_(bf_lo(gw.z)); o1[1] = v1[1] * sigmoidf_(bf_hi(gw.z)); o1[2] = v1[2] * sigmoidf_(bf_lo(gw.w)); o1[3] = v1[3] * sigmoidf_(bf_hi(gw.w));
                    if (prompt) { u32x4 w; w.x = cvt_pk_bf16(o0[0], o0[1]); w.y = cvt_pk_bf16(o0[2], o0[3]); w.z = cvt_pk_bf16(o1[0], o1[1]); w.w = cvt_pk_bf16(o1[2], o1[3]);
                        *(u32x4*)(MG + r * 2048 + c) = w; }
                    else { float* d = MFS + ((size_t)(u.sel * 8 + (u.k0 >> 9)) * 512 + (r - (size_t)prompt_panels * BM)) * 2048 + c;
                        *(f32x4*)d = o0; *(f32x4*)(d + 4) = o1; } }
                asm volatile("" ::: "memory"); }
    }
};
struct EpiOut2 {
    static constexpr bool PERM = true, AFTER_DRAIN = false, HAS_MID = false;
    float* OF; float* OFS; int prompt_panels;
    __device__ __forceinline__ void operator()(const f32x4 (&acc)[2][2][4][2], const Unit& u, int wr, int wc, int fr, int fq) const {
        asm volatile("" : "+v"(fr), "+v"(fq));
        const int row0 = u.pm * BM + wr * 64 + fr, col0 = u.pn * BM + wc * 32 + 8 * fq; const bool prompt = u.pm < prompt_panels;
#pragma unroll
        for (int ai = 0; ai < 2; ++ai)
#pragma unroll
            for (int m = 0; m < 4; ++m) { const size_t r = (size_t)(row0 + ai * HALF + m * 16);
                float* rp = prompt ? OF + r * 2048 + col0 : OFS + ((size_t)(u.k0 >> 8) * 512 + (r - (size_t)prompt_panels * BM)) * 2048 + col0;
#pragma unroll
                for (int bj = 0; bj < 2; ++bj) { *(f32x4*)(rp + bj * HALF) = acc[ai][bj][m][0]; *(f32x4*)(rp + bj * HALF + 4) = acc[ai][bj][m][1]; } }
    }
};
struct DualOrder {
    int G, c;
    __device__ __forceinline__ bool next(int i, Unit& u) const {
        const int nd = c < 256 ? (256 - c + G - 1) / G : 0;
        if (i < 16 * nd) { const int j = c + (i >> 4) * G, vj = (j & 7) * 32 + (j >> 3), q = i & 15;
            u.pm = vj >> 3; u.pn = vj & 7; u.sel = q >> 3; u.k0 = (q & 7) * 512; u.nt = 8; u.mode = (q == 15) ? 2 : 1; return true; }
        const int s = c + (i - 16 * nd) * G; if (s >= 256) return false;
        const int ks = s & 15; u.pm = 32 + (s >> 7); u.pn = (s >> 4) & 7; u.sel = ks >> 3; u.k0 = (ks & 7) * 512; u.nt = 8; u.mode = 0; return true;
    }
    __device__ __forceinline__ void a_ready(const Unit&) const {}
    __device__ __forceinline__ void done(const Unit&) const {}
};
struct OutOrder {
    int G, c;
    __device__ __forceinline__ bool next(int i, Unit& u) const {
        const int nd = c < 256 ? (256 - c + G - 1) / G : 0;
        if (i < nd) { const int j = c + i * G, vj = (j & 7) * 32 + (j >> 3); u.pm = vj >> 3; u.pn = vj & 7; u.sel = 0; u.k0 = 0; u.nt = 32; u.mode = 0; return true; }
        const int s = c + (i - nd) * G; if (s >= 128) return false;
        u.pm = 32 + (s >> 6); u.pn = (s >> 3) & 7; u.sel = 0; u.k0 = (s & 7) * 256; u.nt = 4; u.mode = 0; return true;
    }
    __device__ __forceinline__ void a_ready(const Unit&) const {}
    __device__ __forceinline__ void done(const Unit&) const {}
};
template <class Epi, class Sched, bool ALIGN_EPI = false, bool SP2 = false>
__device__ __forceinline__ void gemm_phase(PG8_LAS unsigned char* lds, const Gemm g, const Sched& S, const Epi& E) {
    const int tid = threadIdx.x, wid = __builtin_amdgcn_readfirstlane(tid >> 6), lane = tid & 63, wr = wid >> 2, wc = wid & 3, fr = lane & 15, fq = lane >> 4;
    const int K = g.K;
    unsigned voffA[2], voffB[2];
#pragma unroll
    for (int i = 0; i < 2; ++i) { int R, C; stage_rc(tid * 16 + i * 8192, R, C); const int Rb = Epi::PERM ? ((R & ~31) + perm32(R & 31)) : R;
        voffA[i] = (unsigned)(R * K + C) * 2u; voffB[i] = (unsigned)(Rb * K + C) * 2u; }
    const size_t kstep = (size_t)(BK * 2);
    const size_t hstep = (size_t)HALF * K * 2;
    const size_t tstep = 2 * hstep;
    const unsigned ldsw = (unsigned)wid * 1024u;
    const int aoff = lds_byte(wr * 64 + fr, fq * 8), boff = lds_byte(wc * 32 + fr, fq * 8);
#define PG8_SA(b, h) (((b) * 2 + (h)) * HTB)
#define PG8_SB(b, h) ((4 + (b) * 2 + (h)) * HTB)
#define PG8_STAGE(bufoff, gbase, voff) do { _Pragma("unroll") for (int _i = 0; _i < 2; ++_i) \
        __builtin_amdgcn_global_load_lds((const unsigned*)((const char*)(gbase) + (voff)[_i]), (PG8_LAS unsigned*)(lds + (bufoff) + ldsw + _i * 8192), 16, 0, 0); } while (0)
#define PG8_LDA(dst, b, h) do { _Pragma("unroll") for (int m = 0; m < 4; ++m) _Pragma("unroll") for (int k = 0; k < 2; ++k) dst[m][k] = *(const PG8_LAS bf16x8*)(lds + PG8_SA(b, h) + aoff + m * 2048 + k * 1024); } while (0)
#define PG8_LDB(dst, b, h) do { _Pragma("unroll") for (int n = 0; n < 2; ++n) _Pragma("unroll") for (int k = 0; k < 2; ++k) dst[n][k] = *(const PG8_LAS bf16x8*)(lds + PG8_SB(b, h) + boff + n * 2048 + k * 1024); } while (0)
#define PG8_MMA(ai, bj, At, Bt) do { __builtin_amdgcn_s_setprio(1); _Pragma("unroll") for (int m = 0; m < 4; ++m) _Pragma("unroll") for (int n = 0; n < 2; ++n) _Pragma("unroll") for (int k = 0; k < 2; ++k) \
        acc[ai][bj][m][n] = __builtin_amdgcn_mfma_f32_16x16x32_bf16(Bt[n][k], At[m][k], acc[ai][bj][m][n], 0, 0, 0); __builtin_amdgcn_s_setprio(0); } while (0)
#define PG8_WAIT_V(n) asm volatile("s_waitcnt vmcnt(" #n ")" ::: "memory")
#define PG8_WAIT_L(n) asm volatile("s_waitcnt lgkmcnt(" #n ")" ::: "memory")
#define PG8_BAR __builtin_amdgcn_s_barrier()
#define PG8_SCHED __builtin_amdgcn_sched_barrier(0)
    Unit cur, nxt; int ui = 0;
    if (!S.next(0, cur)) return;
    f32x4 acc[2][2][4][2];
#pragma unroll
    for (int a = 0; a < 2; ++a)
#pragma unroll
        for (int b = 0; b < 2; ++b)
#pragma unroll
            for (int m = 0; m < 4; ++m)
#pragma unroll
                for (int n = 0; n < 2; ++n) acc[a][b][m][n] = (f32x4){0.f, 0.f, 0.f, 0.f};
    bf16x8 At[4][2], B0[2][2], B1[2][2];
    const char* cA = (const char*)(cur.sel ? g.A2 : g.A) + (size_t)cur.pm * tstep + (size_t)cur.k0 * 2; const char* cB = (const char*)(cur.sel ? g.Bt2 : g.Bt) + (size_t)cur.pn * tstep + (size_t)cur.k0 * 2;
    S.a_ready(cur);
    if constexpr (SP2) {
        PG8_STAGE(PG8_SB(0, 0), cB, voffB); PG8_STAGE(PG8_SB(0, 1), cB + hstep, voffB); PG8_STAGE(PG8_SA(0, 0), cA, voffA); PG8_STAGE(PG8_SA(0, 1), cA + hstep, voffA);
        if (wr == 1) PG8_BAR;
        PG8_WAIT_V(2); PG8_BAR;
        PG8_STAGE(PG8_SB(1, 0), cB + kstep, voffB); PG8_STAGE(PG8_SA(1, 0), cA + kstep, voffA); PG8_STAGE(PG8_SB(1, 1), cB + hstep + kstep, voffB);
        PG8_WAIT_V(6); PG8_BAR;
    } else {
        PG8_STAGE(PG8_SB(0, 0), cB, voffB); PG8_STAGE(PG8_SA(0, 0), cA, voffA); PG8_STAGE(PG8_SB(0, 1), cB + hstep, voffB); PG8_STAGE(PG8_SA(0, 1), cA + hstep, voffA);
        if (wr == 1) PG8_BAR;
        PG8_WAIT_V(4); PG8_BAR;
        PG8_STAGE(PG8_SB(1, 0), cB + kstep, voffB); PG8_STAGE(PG8_SA(1, 0), cA + kstep, voffA); PG8_STAGE(PG8_SB(1, 1), cB + hstep + kstep, voffB);
        PG8_WAIT_V(6); PG8_BAR;
    }
    for (;;) {
        const bool has_next = S.next(ui + 1, nxt);
        const char* nA = has_next ? (const char*)(nxt.sel ? g.A2 : g.A) + (size_t)nxt.pm * tstep + (size_t)nxt.k0 * 2 : cA; const char* nB = has_next ? (const char*)(nxt.sel ? g.Bt2 : g.Bt) + (size_t)nxt.pn * tstep + (size_t)nxt.k0 * 2 : cB;
        const int nt = cur.nt;
        float pre[16];
        if constexpr (Epi::HAS_MID) { if (cur.mode == 1) E.pre(pre, cur, wr, fr); }
        for (int t = 0; t < nt; t += 2) {
            const bool last = (t == nt - 2);
            const char* a1 = cA + (size_t)(t + 1) * kstep;
            const char* a2 = last ? nA : cA + (size_t)(t + 2) * kstep; const char* b2 = last ? nB : cB + (size_t)(t + 2) * kstep;
            const char* a3 = a2 + kstep; const char* b3 = b2 + kstep;
            if (last && has_next) S.a_ready(nxt);
            if constexpr (SP2) {
            PG8_LDB(B0, 0, 0); PG8_LDB(B1, 0, 1); PG8_SCHED; PG8_LDA(At, 0, 0); PG8_STAGE(PG8_SA(1, 1), a1 + hstep, voffA);
            PG8_WAIT_V(8); PG8_WAIT_L(0); PG8_BAR; PG8_MMA(0, 0, At, B0); PG8_MMA(0, 1, At, B1); PG8_BAR; PG8_SCHED;
            PG8_LDA(At, 0, 1); PG8_STAGE(PG8_SB(0, 0), b2, voffB); PG8_STAGE(PG8_SB(0, 1), b2 + hstep, voffB); PG8_STAGE(PG8_SA(0, 0), a2, voffA);
            PG8_WAIT_V(8); PG8_WAIT_L(0); PG8_BAR; PG8_MMA(1, 0, At, B0); PG8_MMA(1, 1, At, B1); PG8_BAR; PG8_SCHED;
            PG8_LDB(B0, 1, 0); PG8_LDB(B1, 1, 1); PG8_SCHED; PG8_LDA(At, 1, 0); PG8_STAGE(PG8_SA(0, 1), a2 + hstep, voffA);
            PG8_WAIT_V(8); PG8_WAIT_L(0); PG8_BAR; PG8_MMA(0, 0, At, B0); PG8_MMA(0, 1, At, B1); PG8_BAR; PG8_SCHED;
            PG8_LDA(At, 1, 1); PG8_STAGE(PG8_SB(1, 0), b3, voffB); PG8_STAGE(PG8_SB(1, 1), b3 + hstep, voffB); PG8_STAGE(PG8_SA(1, 0), a3, voffA);
            PG8_WAIT_V(8); PG8_WAIT_L(0); PG8_BAR; PG8_MMA(1, 0, At, B0); PG8_MMA(1, 1, At, B1); PG8_BAR; PG8_SCHED;
            } else {
            PG8_LDB(B0, 0, 0); PG8_SCHED; PG8_LDA(At, 0, 0); PG8_STAGE(PG8_SA(1, 1), a1 + hstep, voffA);
            PG8_WAIT_L(8); PG8_BAR; PG8_WAIT_L(0); PG8_MMA(0, 0, At, B0); PG8_BAR; PG8_SCHED;
            PG8_LDB(B1, 0, 1); PG8_STAGE(PG8_SB(0, 0), b2, voffB);
            PG8_BAR; PG8_WAIT_L(0); PG8_MMA(0, 1, At, B1); PG8_BAR;
            PG8_LDA(At, 0, 1); PG8_STAGE(PG8_SA(0, 0), a2, voffA);
            PG8_BAR; PG8_WAIT_L(0); PG8_MMA(1, 0, At, B0); PG8_BAR; PG8_SCHED;
            PG8_STAGE(PG8_SB(0, 1), b2 + hstep, voffB);
            PG8_WAIT_V(6); PG8_BAR; PG8_MMA(1, 1, At, B1); PG8_BAR;
            PG8_LDB(B0, 1, 0); PG8_SCHED; PG8_LDA(At, 1, 0); PG8_STAGE(PG8_SA(0, 1), a2 + hstep, voffA);
            PG8_WAIT_L(8); PG8_BAR; PG8_WAIT_L(0); PG8_MMA(0, 0, At, B0); PG8_BAR; PG8_SCHED;
            PG8_LDB(B1, 1, 1); PG8_STAGE(PG8_SB(1, 0), b3, voffB);
            PG8_BAR; PG8_WAIT_L(0); PG8_MMA(0, 1, At, B1); PG8_BAR;
            PG8_LDA(At, 1, 1); PG8_STAGE(PG8_SA(1, 0), a3, voffA);
            PG8_BAR; PG8_WAIT_L(0); PG8_MMA(1, 0, At, B0); PG8_BAR; PG8_SCHED;
            PG8_STAGE(PG8_SB(1, 1), b3 + hstep, voffB);
            PG8_WAIT_V(6); PG8_BAR; PG8_MMA(1, 1, At, B1); PG8_BAR;
            }
        }
        if constexpr (ALIGN_EPI) { if (wr == 0) PG8_BAR; }
        bool keep = false;
        if constexpr (Epi::HAS_MID) { if (cur.mode == 1) { E.mid(acc, cur, pre, wr, wc, fr, fq); keep = true; } }
        if constexpr (!Epi::AFTER_DRAIN) { if (!keep) { E(acc, cur, wr, wc, fr, fq); S.done(cur); } }
        if (!has_next) break;
        if (!keep) {
#pragma unroll
        for (int a = 0; a < 2; ++a)
#pragma unroll
            for (int b = 0; b < 2; ++b)
#pragma unroll
                for (int m = 0; m < 4; ++m)
#pragma unroll
                    for (int n = 0; n < 2; ++n) acc[a][b][m][n] = (f32x4){0.f, 0.f, 0.f, 0.f};
        }
        cur = nxt; cA = nA; cB = nB; ++ui;
        if constexpr (ALIGN_EPI) { if (wr == 1) PG8_BAR; }
    }
    PG8_WAIT_V(0);
    if constexpr (!ALIGN_EPI) { if (wr == 0) PG8_BAR; }
    PG8_BAR;
    if constexpr (Epi::AFTER_DRAIN) { E.fused(acc, cur, wr, wc, fr, fq, lds, wid, lane); S.done(cur); }
#undef PG8_SA
#undef PG8_SB
#undef PG8_STAGE
#undef PG8_LDA
#undef PG8_LDB
#undef PG8_MMA
#undef PG8_WAIT_V
#undef PG8_WAIT_L
#undef PG8_BAR
#undef PG8_SCHED
}
}

#define GAS __attribute__((address_space(1)))
#define LAS __attribute__((address_space(3)))
typedef unsigned short bf16;
typedef unsigned v4u __attribute__((ext_vector_type(4)));
typedef unsigned v2u __attribute__((ext_vector_type(2)));
typedef float f32x4 __attribute__((ext_vector_type(4)));
typedef short bf16x8 __attribute__((ext_vector_type(8)));

constexpr int NWAVES = 8;
constexpr int DM = 2048;
constexpr int NPR = 8192, NSM = 512, MT = NPR + NSM;
constexpr int SEQ = 2048, PB = 4, SB = 128, SL = 4, PAST = 16384;
constexpr int INNER = 4096, CONVD = 6144, NH = 64, NG = 8, NST = 128;
constexpr int RH = 8, RDK = 256, RDV = 512;
constexpr int IN_DIM = 26688, LDP = 26880, NTILE_IN = LDP / 256, DT_TILE = 104;
constexpr int C_Z = 0, C_XBC = 4096, C_Q = 10240, C_K = 12288, C_V = 14336, C_G = 18432, C_GATE = 22528, C_DT = 26624;
constexpr float EPS = 1e-6f;
constexpr int NCT_P = LDP / 128, NCT_X = CONVD / 128; static_assert(NCT_P == pg8::PROJ_NCT, "PROJ tiles");

constexpr size_t MiB = 1u << 20;
constexpr size_t WS_CTL = 0, CTL_ZERO_BYTES = 1 * MiB;
constexpr size_t WS_WTIN = 1 * MiB;
constexpr size_t WS_WTPS = 106 * MiB;
constexpr size_t WS_WTPR = 122 * MiB;
constexpr size_t WS_WTO  = 138 * MiB;
constexpr size_t WS_HN   = 146 * MiB;
constexpr size_t WS_PROJ = 180 * MiB;
constexpr size_t WS_DT   = 627 * MiB;
constexpr size_t WS_DTV  = 630 * MiB;
constexpr size_t WS_LA   = 633 * MiB;
constexpr size_t WS_XBCA = 636 * MiB;
constexpr size_t WS_YS   = 738 * MiB;
constexpr size_t WS_YR   = 806 * MiB;
constexpr size_t WS_MF   = 874 * MiB;
constexpr size_t WS_MG   = 942 * MiB;
constexpr size_t WS_OF   = 976 * MiB;
constexpr size_t WS_YSP0 = 1044 * MiB, WS_YSP1 = 1180 * MiB;
constexpr size_t WS_YRP0 = 1316 * MiB, WS_YRP1 = 1452 * MiB, WS_YRP2 = 1588 * MiB, WS_YRP3 = 1724 * MiB;
constexpr size_t WS_ACS  = 1860 * MiB;
constexpr size_t WS_MFS  = 1863 * MiB;
constexpr size_t WS_OFS  = 1927 * MiB;
constexpr size_t WS_COS  = 1959 * MiB, WS_SIN = 1961 * MiB;
constexpr size_t WS_RSTD = 1963 * MiB;
constexpr size_t WS_END  = 1964 * MiB;
constexpr size_t WS_STS = WS_YSP0, WS_SPS = WS_YSP0 + 64 * MiB;
constexpr size_t WS_STR = WS_YSP1, WS_SPR = WS_YRP0;
static_assert(WS_WTIN + (size_t)LDP * DM * 2 <= WS_WTPS && WS_PROJ + (size_t)MT * LDP * 2 <= WS_DT && WS_XBCA + (size_t)MT * CONVD * 2 <= WS_YS, "ws map");
constexpr int CW_TMO = 0, CW_BAR = 4096;

constexpr size_t O_YP = 0, O_YS = 16777216, O_CONVP = O_YS + 1048576, O_SSMP = O_CONVP + 73728, O_RETP = O_SSMP + 2097152,
                 O_CONVS = O_RETP + 4194304, O_SSMS = O_CONVS + 2359296, O_RETS = O_SSMS + 67108864, O_END = O_RETS + 134217728;

constexpr int RING_OFF = 0, RING_BYTES = 131072, LDSCTL_OFF = 147456, MISC_OFF = LDSCTL_OFF + 320, LDS_BYTES = 163840;

#define LDS_WAIT() asm volatile("s_waitcnt lgkmcnt(0)" ::: "memory")
#define VM_WAIT() asm volatile("s_waitcnt vmcnt(0)" ::: "memory")
__device__ __forceinline__ unsigned f2bf(float f) { unsigned u = __builtin_bit_cast(unsigned, f); return (u + 0x7fffu + ((u >> 16) & 1u)) >> 16; }
typedef __bf16 hwbf2 __attribute__((ext_vector_type(2)));
typedef float hwf2 __attribute__((ext_vector_type(2)));
__device__ __forceinline__ unsigned pk2(float lo, float hi) { const hwf2 v = {lo, hi}; return __builtin_bit_cast(unsigned, __builtin_convertvector(v, hwbf2)); }
__device__ __forceinline__ size_t toff(int row, int col, int nct) { return ((size_t)(row >> 7) * nct + (col >> 7)) * 16384 + (size_t)(row & 127) * 128 + (col & 127); }
__device__ __forceinline__ float bflo(unsigned w) { return __uint_as_float(w << 16); }
__device__ __forceinline__ float bfhi(unsigned w) { return __uint_as_float(w & 0xffff0000u); }
__device__ __forceinline__ float bf2f(bf16 b) { return __uint_as_float(((unsigned)b) << 16); }
__device__ __forceinline__ float sigm(float x) { return __builtin_amdgcn_rcpf(1.0f + __expf(-x)); }
__device__ __forceinline__ float siluf(float x) { return x * __builtin_amdgcn_rcpf(1.0f + __expf(-x)); }
__device__ __forceinline__ float wave_sum(float v) {
#pragma unroll
    for (int o = 1; o < 64; o <<= 1) v += __shfl_xor(v, o);
    return v;
}
#define XB_TMO      128
#define XB_XCNT(j)  (256  + 64 * (j))
#define XB_XSUB(j)  (1280 + 64 * (j))
#define XB_XGEN(j)  (2304 + 64 * (j))
#define XB_TOP      3328
#define XB_TOPGEN   3392
#define XCD_BAR_WORDS 3456
#define XB_SPIN_CAP (1u << 18)

__device__ __forceinline__ unsigned xb_ld(unsigned* p)              { return __hip_atomic_load(p, __ATOMIC_RELAXED, __HIP_MEMORY_SCOPE_AGENT); }
__device__ __forceinline__ unsigned xb_add(unsigned* p, unsigned v) { return __hip_atomic_fetch_add(p, v, __ATOMIC_RELAXED, __HIP_MEMORY_SCOPE_AGENT); }
__device__ __forceinline__ unsigned xb_xcc_id() { return (unsigned)__builtin_amdgcn_s_getreg((3 << 11) | 20) & 0xFu; }
#define XB_SPIN(cond, bar) do { unsigned _sp = 0; while (cond) { __builtin_amdgcn_s_sleep(1); \
    if ((++_sp & 255u) == 0u) { if (xb_ld(&(bar)[XB_TMO])) break; if (_sp > XB_SPIN_CAP) { atomicAdd(&(bar)[XB_TMO], 1u); break; } } } } while (0)

struct XcdBarrier {
    unsigned* bar; unsigned x;
    volatile LAS unsigned* st;
};

__device__ __forceinline__ XcdBarrier xcd_barrier_post(unsigned* bar, volatile LAS unsigned* st) {
    XcdBarrier b; b.bar = bar; b.x = xb_xcc_id(); b.st = st;
    if (threadIdx.x == 0) (void)xb_add(&bar[XB_XCNT(b.x)], 1u);
    return b;
}
__device__ __forceinline__ void xcd_barrier_complete(unsigned* bar, unsigned x, unsigned& nloc, unsigned& nx) {
    const unsigned G = gridDim.x * gridDim.y * gridDim.z;
    unsigned sum, cnt, mine, sp = 0u;
    for (;;) {
        sum = 0u; cnt = 0u; mine = 0u;
#pragma unroll
        for (unsigned j = 0; j < 16; ++j) { const unsigned c = xb_ld(&bar[XB_XCNT(j)]); sum += c; cnt += (c > 0u) ? 1u : 0u; mine = (j == x) ? c : mine; }
        if (sum == G) break;
        __builtin_amdgcn_s_sleep(1);
        if ((++sp & 255u) == 0u) { if (xb_ld(&bar[XB_TMO])) break; if (sp > XB_SPIN_CAP) { atomicAdd(&bar[XB_TMO], 1u); break; } }
    }
    nloc = mine > 0u ? mine : 1u; nx = cnt > 0u ? cnt : 1u;
}

__device__ __forceinline__ void xcd_barrier(const XcdBarrier& b) {
    asm volatile("s_waitcnt vmcnt(0)" ::: "memory");
    __syncthreads();
    if (threadIdx.x == 0) {
        unsigned* bar = b.bar;
        __builtin_amdgcn_s_waitcnt(0);
        unsigned nloc = b.st[0], nx = b.st[1];
        if (nloc == 0u) { xcd_barrier_complete(bar, b.x, nloc, nx); b.st[0] = nloc; b.st[1] = nx; }
        const unsigned old = xb_add(&bar[XB_XSUB(b.x)], 1u);
        const unsigned gen = old / nloc;
        if (old + 1u == (gen + 1u) * nloc) {
            __builtin_amdgcn_fence(__ATOMIC_RELEASE, "agent");
            asm volatile("s_waitcnt vmcnt(0)" ::: "memory");
            const unsigned og = xb_add(&bar[XB_TOP], 1u);
            const unsigned tg = og / nx;
            if (og + 1u == (tg + 1u) * nx) xb_add(&bar[XB_TOPGEN], 1u);
            else XB_SPIN(xb_ld(&bar[XB_TOPGEN]) == tg, bar);
            __builtin_amdgcn_fence(__ATOMIC_ACQUIRE, "agent");
            xb_add(&bar[XB_XGEN(b.x)], 1u);
            asm volatile("s_waitcnt vmcnt(0)" ::: "memory");
        } else {
            XB_SPIN(xb_ld(&bar[XB_XGEN(b.x)]) == gen, bar);
            __builtin_amdgcn_fence(__ATOMIC_ACQUIRE, "agent");
            asm volatile("s_waitcnt vmcnt(0)" ::: "memory");
        }
    }
    __syncthreads();
}

struct Args { const float* in[17]; float* out; unsigned char* ws; int ph_lo, ph_hi; };
enum { I_XP = 0, I_XS, I_CCONV, I_SSSM, I_SRET, I_WPRE, I_WIN, I_CONVW, I_CONVB, I_DTB, I_ALOG, I_DSKIP, I_SNW, I_WPS, I_WPR, I_WOUT, I_WPOST };

__device__ __forceinline__ void p0_transpose_item(const float* W, int K, int N, bf16* WT, int k0, int n0, int dst_row0, LAS float* scr, int lane) {
    float tv[64];
#pragma unroll
    for (int i = 0; i < 64; ++i) tv[i] = W[(size_t)(k0 + i) * N + n0 + lane];
#pragma unroll
    for (int i = 0; i < 64; ++i) scr[i * 65 + lane] = tv[i];
    LDS_WAIT(); asm volatile("" ::: "memory");
    const int c = lane & 7;
#pragma unroll
    for (int j = 0; j < 8; ++j) { const int n = (lane >> 3) + 8 * j; const LAS float* s = scr + (8 * c) * 65 + n;
        v4u o; o.x = pk2(s[0 * 65], s[1 * 65]); o.y = pk2(s[2 * 65], s[3 * 65]); o.z = pk2(s[4 * 65], s[5 * 65]); o.w = pk2(s[6 * 65], s[7 * 65]);
        *(GAS v4u*)(WT + (size_t)(dst_row0 + n) * K + k0 + 8 * c) = o; }
    LDS_WAIT(); asm volatile("" ::: "memory");
}
__device__ __forceinline__ const float* x_row(const Args& a, int m) { return m < NPR ? a.in[I_XP] + (size_t)m * DM : a.in[I_XS] + (size_t)(m - NPR) * DM; }

__device__ __forceinline__ void p0_prologue(const Args& a, LAS unsigned char* lds, int wave, int lane) {
    LAS float* scr = (LAS float*)(lds + RING_OFF + wave * 16896);
    const int gw = blockIdx.x * NWAVES + wave, NGW = gridDim.x * NWAVES;
    bf16* WTIN = (bf16*)(a.ws + WS_WTIN); bf16* WTPS = (bf16*)(a.ws + WS_WTPS); bf16* WTPR = (bf16*)(a.ws + WS_WTPR); bf16* WTO = (bf16*)(a.ws + WS_WTO);
    constexpr int NB_IN = IN_DIM / 64;
    constexpr int I_IN = (DM / 64) * NB_IN, I_PS = (INNER / 64) * (DM / 64), I_PR = I_PS, I_O = (DM / 64) * (DM / 64);
    constexpr int NITEMS = I_IN + I_PS + I_PR + I_O;
    for (int it = gw; it < NITEMS; it += NGW) {
        int r = it;
        if (r < I_IN) { const int kb = r / NB_IN, nb = r % NB_IN, n0 = 64 * nb; const int d0 = n0 < 10240 ? n0 : (n0 < 10304 ? n0 + 16384 : n0 - 64);
            p0_transpose_item(a.in[I_WIN], DM, IN_DIM, WTIN, 64 * kb, n0, d0, scr, lane); continue; }
        r -= I_IN;
        if (r < I_PS) { const int kb = r / (DM / 64), nb = r % (DM / 64); p0_transpose_item(a.in[I_WPS], INNER, DM, WTPS, 64 * kb, 64 * nb, 64 * nb, scr, lane); continue; }
        r -= I_PS;
        if (r < I_PR) { const int kb = r / (DM / 64), nb = r % (DM / 64); p0_transpose_item(a.in[I_WPR], INNER, DM, WTPR, 64 * kb, 64 * nb, 64 * nb, scr, lane); continue; }
        r -= I_PR;
        { const int kb = r / (DM / 64), nb = r % (DM / 64); p0_transpose_item(a.in[I_WOUT], DM, DM, WTO, 64 * kb, 64 * nb, 64 * nb, scr, lane); }
    }
    { GAS v4u* z = (GAS v4u*)(WTIN + (size_t)IN_DIM * DM); const int nz = (LDP - IN_DIM) * DM / 8;
      for (int i = blockIdx.x * 512 + threadIdx.x; i < nz; i += gridDim.x * 512) z[i] = (v4u){0u, 0u, 0u, 0u}; }
    { float* COS = (float*)(a.ws + WS_COS); float* SIN = (float*)(a.ws + WS_SIN);
      for (int i = blockIdx.x * 512 + threadIdx.x; i < 2052 * 128; i += gridDim.x * 512) { const int pi = i >> 7, f = i & 127, pos = pi < 2048 ? pi : PAST + (pi - 2048);
          const double inv = exp2(-(double)f * (13.287712379549449 / 128.0)), ang = (double)pos * inv; COS[i] = (float)cos(ang); SIN[i] = (float)sin(ang); } }
    bf16* HN = (bf16*)(a.ws + WS_HN);
    const GAS f32x4* wp = (const GAS f32x4*)a.in[I_WPRE] + lane;
    for (int m = gw; m < MT; m += NGW) {
        const GAS f32x4* xr = (const GAS f32x4*)x_row(a, m) + lane;
        f32x4 v[8]; float s = 0.f;
#pragma unroll
        for (int j = 0; j < 8; ++j) { v[j] = xr[64 * j]; s += (v[j].x * v[j].x + v[j].y * v[j].y) + (v[j].z * v[j].z + v[j].w * v[j].w); }
        const float rstd = 1.0f / sqrtf(wave_sum(s) * (1.0f / DM) + EPS);
        GAS v2u* o8 = (GAS v2u*)(HN + (size_t)m * DM) + lane;
#pragma unroll
        for (int j = 0; j < 8; ++j) { const f32x4 w = wp[64 * j]; v2u o; o.x = pk2(v[j].x * rstd * w.x, v[j].y * rstd * w.y); o.y = pk2(v[j].z * rstd * w.z, v[j].w * rstd * w.w); o8[64 * j] = o; }
    }
}

__device__ __forceinline__ void p2_prep(const Args& a, LAS unsigned char* lds) {
    const bf16* PROJ = (const bf16*)(a.ws + WS_PROJ); bf16* PROJW = (bf16*)(a.ws + WS_PROJ);
    bf16* XBCA = (bf16*)(a.ws + WS_XBCA);
    const size_t gt = (size_t)blockIdx.x * 512 + threadIdx.x, NT = (size_t)gridDim.x * 512;
    const float* cw = a.in[I_CONVW]; const float* cb = a.in[I_CONVB]; const float* cache = a.in[I_CCONV];
    for (size_t it = gt; it < (size_t)(MT / 32) * (CONVD / 8); it += NT) {
        const int cg = (int)(it % (CONVD / 8)), seg = (int)(it / (CONVD / 8)), j0 = cg * 8, m0 = seg * 32;
        float w[4][8], bs[8], x0[8], x1[8], x2[8];
#pragma unroll
        for (int e = 0; e < 8; ++e) { bs[e] = cb[j0 + e];
#pragma unroll
            for (int tap = 0; tap < 4; ++tap) w[tap][e] = cw[tap * CONVD + j0 + e]; }
#define UNPK8(dst, v) do { dst[0] = bflo(v.x); dst[1] = bfhi(v.x); dst[2] = bflo(v.y); dst[3] = bfhi(v.y); dst[4] = bflo(v.z); dst[5] = bfhi(v.z); dst[6] = bflo(v.w); dst[7] = bfhi(v.w); } while (0)
        if (m0 < NPR && (m0 % SEQ) != 0) { const v4u v0 = *(const v4u*)(PROJ + toff(m0 - 3, C_XBC + j0, NCT_P)), v1 = *(const v4u*)(PROJ + toff(m0 - 2, C_XBC + j0, NCT_P)), v2 = *(const v4u*)(PROJ + toff(m0 - 1, C_XBC + j0, NCT_P));
            UNPK8(x0, v0); UNPK8(x1, v1); UNPK8(x2, v2); }
        else {
#pragma unroll
            for (int e = 0; e < 8; ++e) { x0[e] = 0.f; x1[e] = 0.f; x2[e] = 0.f; } }
#pragma unroll 1
        for (int r0 = 0; r0 < 32; r0 += 8) { v4u vv[8];
#pragma unroll
          for (int q = 0; q < 8; ++q) vv[q] = *(const v4u*)(PROJ + toff(m0 + r0 + q, C_XBC + j0, NCT_P));
#pragma unroll
          for (int q = 0; q < 8; ++q) { const int m = m0 + r0 + q;
            if (m >= NPR && ((m - NPR) % SL) == 0) { const float* cp = cache + (size_t)((m - NPR) / SL) * 3 * CONVD + j0;
#pragma unroll
                for (int e = 0; e < 8; ++e) { x0[e] = cp[e]; x1[e] = cp[CONVD + e]; x2[e] = cp[2 * CONVD + e]; } }
            const v4u v = vv[q]; float x3[8]; UNPK8(x3, v);
            float o[8];
#pragma unroll
            for (int e = 0; e < 8; ++e) { o[e] = siluf(bs[e] + w[0][e] * x0[e] + w[1][e] * x1[e] + w[2][e] * x2[e] + w[3][e] * x3[e]); x0[e] = x1[e]; x1[e] = x2[e]; x2[e] = x3[e]; }
            v4u ov; ov.x = pk2(o[0], o[1]); ov.y = pk2(o[2], o[3]); ov.z = pk2(o[4], o[5]); ov.w = pk2(o[6], o[7]);
            *(v4u*)(XBCA + toff(m, j0, NCT_X)) = ov; } }
#undef UNPK8
    }
    for (size_t i = gt; i < (size_t)(PB + SB) * 3 * CONVD; i += NT) {
        const int j = (int)(i % CONVD), bi = (int)(i / CONVD), ii = bi % 3, b = bi / 3;
        if (b < PB) a.out[O_CONVP + ((size_t)b * 3 + ii) * CONVD + j] = bf2f(PROJ[toff(b * SEQ + SEQ - 3 + ii, C_XBC + j, NCT_P)]);
        else { const int bs = b - PB; a.out[O_CONVS + ((size_t)bs * 3 + ii) * CONVD + j] = bf2f(PROJ[toff(NPR + bs * SL + 1 + ii, C_XBC + j, NCT_P)]); }
    }
    { const float* DT = (const float*)(a.ws + WS_DT); float* DTV = (float*)(a.ws + WS_DTV); float* LA = (float*)(a.ws + WS_LA);
      for (size_t i = gt; i < (size_t)MT * NH; i += NT) { const int h = (int)(i & 63); const float x = DT[i] + a.in[I_DTB][h];
          const float sp = x > 20.f ? x : log1pf(expf(x)); DTV[i] = sp; LA[i] = -sp * expf(a.in[I_ALOG][h]); }
      float* ACS = (float*)(a.ws + WS_ACS); const int lane = threadIdx.x & 63, wv = threadIdx.x >> 6;
      const float bias = a.in[I_DTB][lane], an = -expf(a.in[I_ALOG][lane]);
      LAS float* WT = (LAS float*)(lds + 8192);
      for (int ck = blockIdx.x; ck < NPR / 128; ck += gridDim.x) { float cs[16]; float acc = 0.f;
#pragma unroll
          for (int e = 0; e < 16; ++e) cs[e] = DT[(size_t)(ck * 128 + wv * 16 + e) * NH + lane] + bias;
#pragma unroll
          for (int e = 0; e < 16; ++e) { const float sp = cs[e] > 20.f ? cs[e] : log1pf(expf(cs[e])); acc += sp * an; cs[e] = acc; }
          __syncthreads(); WT[wv * 64 + lane] = acc; __syncthreads();
          float off = 0.f;
#pragma unroll
          for (int w2 = 0; w2 < 8; ++w2) off += (w2 < wv) ? WT[w2 * 64 + lane] : 0.f;
#pragma unroll
          for (int e = 0; e < 16; ++e) ACS[(size_t)(ck * 128 + wv * 16 + e) * NH + lane] = off + cs[e]; } }
}

__device__ __forceinline__ void p8_final(const Args& a, int wave, int lane) {
    const float* OF = (const float*)(a.ws + WS_OF);
    const int gw = blockIdx.x * NWAVES + wave, NGW = gridDim.x * NWAVES;
    const GAS f32x4* wp = (const GAS f32x4*)a.in[I_WPOST] + lane;
    for (int m = gw; m < MT; m += NGW) {
        const GAS f32x4* orow = (const GAS f32x4*)(OF + (size_t)m * DM) + lane; const GAS f32x4* xr = (const GAS f32x4*)x_row(a, m) + lane;
        f32x4 v[8]; float s = 0.f;
#pragma unroll
        for (int j = 0; j < 8; ++j) {
            if (m < NPR) v[j] = orow[64 * j];
            else { const GAS f32x4* ps = (const GAS f32x4*)((const float*)(a.ws + WS_OFS) + (size_t)(m - NPR) * DM) + lane + 64 * j; v[j] = ps[0];
#pragma unroll
                for (int ks = 1; ks < 8; ++ks) v[j] += ps[(size_t)ks * (NSM * DM / 4)]; }
            s += (v[j].x * v[j].x + v[j].y * v[j].y) + (v[j].z * v[j].z + v[j].w * v[j].w); }
        const float rstd = 1.0f / sqrtf(wave_sum(s) * (1.0f / DM) + EPS);
        GAS f32x4* yo = (GAS f32x4*)(a.out + (size_t)m * DM) + lane;
#pragma unroll
        for (int j = 0; j < 8; ++j) { const f32x4 w = wp[64 * j], x = xr[64 * j]; yo[64 * j] = x + v[j] * rstd * w; }
    }
}

__device__ __forceinline__ void p7_merge_sample(const Args& a) {
    const f32x4* src = (const f32x4*)(a.ws + WS_MFS); v4u* dst = (v4u*)((bf16*)(a.ws + WS_MG) + (size_t)NPR * DM);
    for (size_t i = (size_t)blockIdx.x * 512 + threadIdx.x; i < (size_t)NSM * DM / 8; i += (size_t)gridDim.x * 512) { f32x4 x0 = src[2 * i], x1 = src[2 * i + 1];
#pragma unroll
        for (int ks = 1; ks < 16; ++ks) { x0 += src[(size_t)ks * (NSM * DM / 4) + 2 * i]; x1 += src[(size_t)ks * (NSM * DM / 4) + 2 * i + 1]; }
        v4u o; o.x = pk2(x0.x, x0.y); o.y = pk2(x0.z, x0.w); o.z = pk2(x1.x, x1.y); o.w = pk2(x1.z, x1.w); dst[i] = o; }
}

typedef short s4v __attribute__((ext_vector_type(4)));
constexpr int TAB0 = LDSCTL_OFF + 1024, TAB1 = TAB0 + 4096;
static_assert(TAB1 + 4096 <= LDS_BYTES, "LDS tables");
__device__ __forceinline__ unsigned img_off(unsigned row, unsigned ch) { return 256u * row + 16u * (ch ^ (((row & 3u) << 2) | ((row >> 2) & 3u))); }
__device__ __forceinline__ s4v tr_rd(LAS unsigned char* p) { return __builtin_amdgcn_ds_read_tr16_b64_v4i16((LAS s4v*)p); }
__device__ __forceinline__ bf16x8 mk8(s4v a, s4v b) { return (bf16x8){a[0], a[1], a[2], a[3], b[0], b[1], b[2], b[3]}; }
__device__ __forceinline__ float ret_lg2(int hh) { return log2f(1.0f - exp2f(-5.0f - (float)hh)); }
#define MFMA16(a, b, c) __builtin_amdgcn_mfma_f32_16x16x32_bf16((a), (b), (c), 0, 0, 0)

__device__ __forceinline__ unsigned img64_off(unsigned row, unsigned ch) { return 128u * row + 16u * (ch ^ (((row >> 1) & 3u) << 1)); }
__device__ __forceinline__ void dma16(const void* g, LAS unsigned char* l) {
    const unsigned lds_dst = __builtin_amdgcn_readfirstlane((unsigned)(size_t)l); unsigned keep;
    asm volatile("s_mov_b32 %0, m0\n\ts_mov_b32 m0, %2\n\ts_nop 0\n\tglobal_load_lds_dwordx4 %1, off\n\ts_mov_b32 m0, %0" : "=&s"(keep) : "v"(g), "s"(lds_dst) : "memory");
}
template <int NROWS> __device__ __forceinline__ void stage256(const bf16* src, size_t ld, LAS unsigned char* dst, int wave, int lane) {
#pragma unroll
    for (int i0 = 0; i0 < NROWS / 4; i0 += 8) { const int i = i0 + wave, row = 4 * i + (lane >> 4), cs = lane & 15, ch = cs ^ (((row & 3) << 2) | ((row >> 2) & 3));
        dma16(src + (size_t)row * ld + ch * 8, dst + i * 1024); }
}
template <int NROWS> __device__ __forceinline__ void stage128(const bf16* src, size_t ld, LAS unsigned char* dst, int wave, int lane) {
#pragma unroll
    for (int i0 = 0; i0 < NROWS / 8; i0 += 8) { const int i = i0 + wave, row = 8 * i + (lane >> 3), cs = lane & 7, ch = cs ^ (((row >> 1) & 3) << 1);
        dma16(src + (size_t)row * ld + ch * 8, dst + i * 1024); }
}
struct PCtx { unsigned char* ws; const float* dskip; const float* snw; };
template <bool RET> __device__ __forceinline__ void passC_unit(const PCtx a, LAS unsigned char* lds, int b, int c, int gi, int tid, int wave, int lane) {
    constexpr int N = RET ? 256 : 128, NKI = N / 128, NKS = N / 32;
    constexpr int NB = RET ? 2 : 3, BUFSZ = RET ? 65536 : 49152, K_OFF = RET ? 65536 : 114688, S_OFF = 32768, Z_OFF = 16384, TNW_OFF = LDSCTL_OFF + 9216;
    const size_t R0 = (size_t)b * SEQ + (size_t)c * 128;
    const bf16* PROJ = (const bf16*)(a.ws + WS_PROJ); const bf16* XBCA = (const bf16*)(a.ws + WS_XBCA);
    const float* DTV = (const float*)(a.ws + WS_DTV); const float* ACS = (const float*)(a.ws + WS_ACS);
    constexpr size_t ld = 128;
    const bf16* Ksrc = RET ? PROJ + toff((int)R0, C_K + gi * 256, NCT_P) : XBCA + toff((int)R0, INNER + gi * 128, NCT_X);
    const bf16* Qsrc = RET ? PROJ + toff((int)R0, C_Q + gi * 256, NCT_P) : XBCA + toff((int)R0, INNER + NG * NST + gi * 128, NCT_X);
    const bf16* Xsrc = RET ? PROJ + toff((int)R0, C_V + gi * 512, NCT_P) : XBCA + toff((int)R0, gi * 512, NCT_X);
    const bf16* Zsrc = PROJ + toff((int)R0, (RET ? C_G : C_Z) + gi * 512, NCT_P);
    LAS float* TNW = (LAS float*)(lds + TNW_OFF);
    const bf16* SP = (const bf16*)(a.ws + (RET ? WS_SPR : WS_SPS)) + (size_t)((b * 16 + c) * 8 + gi) * 8 * 64 * N;
    bf16* Yout = (bf16*)(a.ws + (RET ? WS_YR : WS_YS)) + R0 * INNER + gi * 512;
    LAS float* TA = (LAS float*)(lds + TAB0); LAS float* TD = (LAS float*)(lds + TAB1);
    const int g4 = lane >> 4, l15 = lane & 15, q4 = l15 >> 2, p4 = lane & 3, L0 = 16 * wave, lrow = L0 + l15;
    const int ps = (p4 == 1) ? 2 : (p4 == 2 ? 1 : p4), gs = (g4 == 1) ? 2 : (g4 == 2 ? 1 : g4), l15s = 4 * ((q4 == 1) ? 2 : (q4 == 2 ? 1 : q4)) + (l15 & 3);
    const bool up = lane >= 32; const int nst = up ? ((g4 == 3) ? 8 : 0) : 4 * gs;
    const float lg2 = RET ? ret_lg2(gi) : 0.f;
#define STAGE_R(r_) do { LAS unsigned char* bb_ = lds + ((r_) % NB) * BUFSZ; \
        stage128<128>(Xsrc + ((r_) >> 1) * 16384 + ((r_) & 1) * 64, ld, bb_, wave, lane); \
        stage128<128>(Zsrc + ((r_) >> 1) * 16384 + ((r_) & 1) * 64, ld, bb_ + Z_OFF, wave, lane); \
        _Pragma("unroll") for (int h_ = 0; h_ < NKI; ++h_) stage256<64>(SP + (size_t)(r_) * 64 * N + h_ * 128, (size_t)N, bb_ + S_OFF + h_ * 16384, wave, lane); } while (0)
    __syncthreads();
#pragma unroll
    for (int h = 0; h < NKI; ++h) stage256<128>(Ksrc + h * 16384, ld, lds + K_OFF + h * 32768, wave, lane);
    STAGE_R(0);
    if (!RET) STAGE_R(1);
    if (!RET) { for (int i = tid; i < 1024; i += 512) { const int r = i >> 7, s = i & 127; TA[i] = ACS[(R0 + s) * NH + gi * 8 + r]; TD[i] = DTV[(R0 + s) * NH + gi * 8 + r]; }
        TNW[tid] = a.snw[gi * 512 + tid]; }
    bf16x8 qf[NKS];
#pragma unroll
    for (int ks = 0; ks < NKS; ++ks) qf[ks] = *(const bf16x8*)(Qsrc + (ks >> 2) * 16384 + (size_t)lrow * ld + 32 * (ks & 3) + 8 * g4);
    asm volatile("s_waitcnt vmcnt(0)" ::: "memory");
    __syncthreads();
    f32x4 gt[8];
#pragma unroll
    for (int si = 0; si < 8; ++si) { gt[si] = (f32x4){0.f, 0.f, 0.f, 0.f};
        if (si <= wave) {
#pragma unroll
            for (int ks = 0; ks < NKS; ++ks) { const bf16x8 ka = *(const LAS bf16x8*)(lds + K_OFF + (ks >> 2) * 32768 + img_off(16 * si + l15, 4 * (ks & 3) + g4)); gt[si] = MFMA16(ka, qf[ks], gt[si]); }
            asm volatile("" ::: "memory"); } }
    bf16x8 mt[4];
    if (RET) {
#pragma unroll
        for (int kp = 0; kp < 4; ++kp) { float v[8];
#pragma unroll
            for (int t = 0; t < 2; ++t)
#pragma unroll
                for (int i = 0; i < 4; ++i) { const int s = 32 * kp + 16 * t + 4 * g4 + i; v[4 * t + i] = (s <= lrow) ? gt[2 * kp + t][i] * exp2f(lg2 * (float)(lrow - s)) : 0.f; }
            const unsigned w0 = pk2(v[0], v[1]), w1 = pk2(v[2], v[3]), w2 = pk2(v[4], v[5]), w3 = pk2(v[6], v[7]);
            mt[kp] = __builtin_bit_cast(bf16x8, (v4u){w0, w1, w2, w3}); }
    }
    float ssq = 0.f;
    __syncthreads();
    if (RET) STAGE_R(1);
#pragma unroll 1
    for (int r = 0; r < 8; ++r) {
        if (RET) { if (r >= 1 && r < 7) STAGE_R(r + 1); }
        else if (r < 6) STAGE_R(r + 2);
        LAS unsigned char* bb = lds + (r % NB) * BUFSZ;
        float el;
        if (RET) el = exp2f(lg2 * (float)(lrow + 1));
        else { const float al = TA[r * 128 + lrow]; el = __expf(al);
#pragma unroll
            for (int kp = 0; kp < 4; ++kp) if (2 * kp <= wave) { float v[8];
#pragma unroll
                for (int t = 0; t < 2; ++t) { const int s0 = 32 * kp + 16 * t + 4 * g4; const f32x4 as = *(const LAS f32x4*)(TA + r * 128 + s0), ds = *(const LAS f32x4*)(TD + r * 128 + s0);
#pragma unroll
                    for (int i = 0; i < 4; ++i) v[4 * t + i] = (s0 + i <= lrow) ? gt[2 * kp + t][i] * __expf(al - as[i]) * ds[i] : 0.f; }
                const unsigned w0 = pk2(v[0], v[1]), w1 = pk2(v[2], v[3]), w2 = pk2(v[4], v[5]), w3 = pk2(v[6], v[7]);
                mt[kp] = __builtin_bit_cast(bf16x8, (v4u){w0, w1, w2, w3}); } }
        const float Dh = RET ? 0.f : a.dskip[gi * 8 + r];
        v2u yp[2];
#pragma unroll 1
        for (int pp2 = 0; pp2 < 2; ++pp2)
#pragma unroll
        for (int ph = 0; ph < 2; ++ph) { const int pt = 2 * pp2 + ph;
            f32x4 ai = (f32x4){0.f, 0.f, 0.f, 0.f}, ae = (f32x4){0.f, 0.f, 0.f, 0.f};
            LAS unsigned char* xb = bb + 8 * (ps & 1);
#pragma unroll
            for (int kp = 0; kp < 4; ++kp) if (2 * kp <= wave) {
                const s4v lo = tr_rd(xb + img64_off(32 * kp + 4 * g4 + q4, 2 * pt + (ps >> 1))), hi = tr_rd(xb + img64_off(32 * kp + 16 + 4 * g4 + q4, 2 * pt + (ps >> 1)));
                ai = MFMA16(mk8(lo, hi), mt[kp], ai); }
#pragma unroll
            for (int ks = 0; ks < NKS; ++ks) { const bf16x8 sa = *(const LAS bf16x8*)(bb + S_OFF + (ks >> 2) * 16384 + img_off(16 * pt + l15s, 4 * (ks & 3) + g4)); ae = MFMA16(sa, qf[ks], ae); }
            float y[4];
#pragma unroll
            for (int i = 0; i < 4; ++i) y[i] = ai[i] + el * ae[i];
            const unsigned xo = img64_off(lrow, 2 * pt + (gs >> 1)) + 8 * (gs & 1);
            const v2u zw = *(const LAS v2u*)(bb + Z_OFF + xo);
            if (!RET) {
                const v2u xw = *(const LAS v2u*)(bb + xo);
                y[0] = (y[0] + Dh * bflo(xw.x)) * siluf(bflo(zw.x)); y[1] = (y[1] + Dh * bfhi(xw.x)) * siluf(bfhi(zw.x));
                y[2] = (y[2] + Dh * bflo(xw.y)) * siluf(bflo(zw.y)); y[3] = (y[3] + Dh * bfhi(xw.y)) * siluf(bfhi(zw.y));
            }
            ssq += (y[0] * y[0] + y[1] * y[1]) + (y[2] * y[2] + y[3] * y[3]);
            if (RET) { y[0] *= siluf(bflo(zw.x)); y[1] *= siluf(bfhi(zw.x)); y[2] *= siluf(bflo(zw.y)); y[3] *= siluf(bfhi(zw.y)); }
            else { const f32x4 nw = *(const LAS f32x4*)(TNW + r * 64 + 16 * pt + 4 * gs); y[0] *= nw.x; y[1] *= nw.y; y[2] *= nw.z; y[3] *= nw.w; }
            yp[ph].x = pk2(y[0], y[1]); yp[ph].y = pk2(y[2], y[3]);
            if (ph) {
                const unsigned sx = up ? yp[0].x : yp[1].x, sy = up ? yp[0].y : yp[1].y; const unsigned rx = (unsigned)__shfl_xor((int)sx, 32), ry = (unsigned)__shfl_xor((int)sy, 32);
                const v4u w = up ? (v4u){rx, ry, yp[1].x, yp[1].y} : (v4u){yp[0].x, yp[0].y, rx, ry};
                *(v4u*)(Yout + (size_t)lrow * INNER + r * 64 + 16 * (pt - 1 + (up ? 1 : 0)) + nst) = w; }
        }
        if (RET) { if (r < 7) asm volatile("s_waitcnt vmcnt(2)" ::: "memory"); else asm volatile("s_waitcnt vmcnt(0)" ::: "memory"); }
        else { if (r < 6) asm volatile("s_waitcnt vmcnt(8)" ::: "memory"); else asm volatile("s_waitcnt vmcnt(0)" ::: "memory"); }
        __builtin_amdgcn_s_barrier();
        asm volatile("" ::: "memory");
    }
#undef STAGE_R
    ssq += __shfl_xor(ssq, 16); ssq += __shfl_xor(ssq, 32);
    if (g4 == 0) ((float*)(a.ws + WS_RSTD))[(R0 + lrow) * 16 + (RET ? 8 : 0) + gi] = 1.0f / sqrtf(ssq * (1.0f / 512.0f) + EPS);
}

__device__ __forceinline__ void passC(unsigned char* ws, const float* dskip, const float* snw, LAS unsigned char* lds) {
    const PCtx a{ws, dskip, snw}; const int tid = threadIdx.x, lane = tid & 63, wave = __builtin_amdgcn_readfirstlane(tid >> 6);
#if !defined(ONLY_SSD)
    for (int u = blockIdx.x; u < 512; u += gridDim.x) passC_unit<true>(a, lds, u >> 7, (u >> 3) & 15, u & 7, tid, wave, lane);
#endif
#if !defined(ONLY_RET)
    for (int u = blockIdx.x; u < 512; u += gridDim.x) passC_unit<false>(a, lds, u >> 7, (u >> 3) & 15, u & 7, tid, wave, lane);
#endif
}

template <bool RET> __device__ __forceinline__ void scan_unit(const Args& a, LAS unsigned char* lds, int b, int gi, int rp, int nh, int tid, int wave, int lane) {
    constexpr int N = RET ? 256 : 128;
    const bf16* PROJ = (const bf16*)(a.ws + WS_PROJ); const bf16* XBCA = (const bf16*)(a.ws + WS_XBCA);
    const float* DTV = (const float*)(a.ws + WS_DTV); const float* ACS = (const float*)(a.ws + WS_ACS);
    constexpr size_t ld = 128, CSTEP = (size_t)(RET ? NCT_P : NCT_X) * 16384;
    const size_t Rb = (size_t)b * SEQ;
    const bf16* Ksrc = RET ? PROJ + toff((int)Rb, C_K + gi * 256 + nh * 128, NCT_P) : XBCA + toff((int)Rb, INNER + gi * 128, NCT_X);
    const bf16* Xsrc = RET ? PROJ + toff((int)Rb, C_V + gi * 512 + rp * 128, NCT_P) : XBCA + toff((int)Rb, gi * 512 + rp * 128, NCT_X);
    bf16* SP = (bf16*)(a.ws + (RET ? WS_SPR : WS_SPS));
    LAS float* TBL = (LAS float*)(lds + 131072);
    const int g4 = lane >> 4, l15 = lane & 15, q4 = l15 >> 2, p4 = lane & 3;
    const int ps = (p4 == 1) ? 2 : (p4 == 2 ? 1 : p4), gs = (g4 == 1) ? 2 : (g4 == 2 ? 1 : g4);
    const bool up = lane >= 32; const int nst = up ? ((g4 == 3) ? 8 : 0) : 4 * gs;
    const float lg2 = RET ? ret_lg2(gi) : 0.f;
    float wb[4], wj[8]; const float decR = RET ? exp2f(lg2 * 128.f) : 0.f;
#pragma unroll
    for (int ks = 0; ks < 4; ++ks) wb[ks] = RET ? exp2f(lg2 * (float)(127 - (32 * ks + 8 * g4))) : 0.f;
#pragma unroll
    for (int j = 0; j < 8; ++j) wj[j] = RET ? exp2f(-lg2 * (float)j) : 0.f;
#define SC_STAGE_K(c_) stage256<128>(Ksrc + (size_t)(c_) * CSTEP, ld, lds + ((2 * (c_)) & 3) * 32768, wave, lane)
#define SC_STAGE_X(c_) stage256<128>(Xsrc + (size_t)(c_) * CSTEP, ld, lds + ((2 * (c_) + 1) & 3) * 32768, wave, lane)
#define SC_TBLVAL(c_, dst) do { if (!RET && tid < 258) { const int rr_ = tid < 256 ? (tid >> 7) : (tid - 256), s_ = tid < 256 ? (tid & 127) : 127; const int h_ = gi * 8 + 2 * rp + rr_; \
            const size_t r0_ = Rb + (size_t)(c_) * 128; const float aend_ = ACS[(r0_ + 127) * NH + h_]; \
            dst = tid < 256 ? DTV[(r0_ + s_) * NH + h_] * __expf(aend_ - ACS[(r0_ + s_) * NH + h_]) : __expf(aend_); } } while (0)
    f32x4 acc[2][4];
#pragma unroll
    for (int rr = 0; rr < 2; ++rr)
#pragma unroll
        for (int pt = 0; pt < 4; ++pt) acc[rr][pt] = (f32x4){0.f, 0.f, 0.f, 0.f};
    __syncthreads();
    SC_STAGE_K(0); SC_STAGE_X(0); SC_STAGE_K(1);
    { float tv = 0.f; SC_TBLVAL(0, tv); if (!RET && tid < 258) TBL[tid] = tv; }
    asm volatile("s_waitcnt vmcnt(0)" ::: "memory");
    __syncthreads();
#pragma unroll 1
    for (int c = 0; c < 16; ++c) {
        if (c < 15) SC_STAGE_X(c + 1);
        bf16x8 kf[4];
        { LAS unsigned char* kb = lds + ((2 * c) & 3) * 32768 + 8 * (ps & 1);
#pragma unroll
          for (int ks = 0; ks < 4; ++ks) { const s4v lo = tr_rd(kb + img_off(32 * ks + 8 * g4 + q4, 2 * wave + (ps >> 1))), hi = tr_rd(kb + img_off(32 * ks + 8 * g4 + 4 + q4, 2 * wave + (ps >> 1)));
            kf[ks] = mk8(lo, hi); } }
        asm volatile("s_waitcnt lgkmcnt(0)" ::: "memory");
        if (c < 15) asm volatile("s_waitcnt vmcnt(12)" ::: "memory"); else asm volatile("s_waitcnt vmcnt(0)" ::: "memory");
        __builtin_amdgcn_s_barrier(); asm volatile("" ::: "memory");
        float tvn = 0.f; if (c < 15) SC_TBLVAL(c + 1, tvn);
        { bf16* sp = SP + ((size_t)((b * 16 + c) * 8 + gi) * 8 + 2 * rp) * 64 * N + (RET ? nh * 128 : 0) + 16 * wave + nst;
#pragma unroll
          for (int rr = 0; rr < 2; ++rr)
#pragma unroll
            for (int pp = 0; pp < 2; ++pp) {
                v2u oe, oo; oe.x = pk2(acc[rr][2 * pp][0], acc[rr][2 * pp][1]); oe.y = pk2(acc[rr][2 * pp][2], acc[rr][2 * pp][3]);
                oo.x = pk2(acc[rr][2 * pp + 1][0], acc[rr][2 * pp + 1][1]); oo.y = pk2(acc[rr][2 * pp + 1][2], acc[rr][2 * pp + 1][3]);
                const unsigned sx = up ? oe.x : oo.x, sy = up ? oe.y : oo.y; const unsigned rx = (unsigned)__shfl_xor((int)sx, 32), ry = (unsigned)__shfl_xor((int)sy, 32);
                const v4u w = up ? (v4u){rx, ry, oo.x, oo.y} : (v4u){oe.x, oe.y, rx, ry};
                *(v4u*)(sp + (size_t)(rr * 64 + 16 * (2 * pp + (up ? 1 : 0)) + l15) * N) = w; } }
        if (c < 14) SC_STAGE_K(c + 2);
        LAS unsigned char* xb0 = lds + ((2 * c + 1) & 3) * 32768; LAS float* T = TBL + (c & 1) * 512;
#pragma unroll
        for (int rr = 0; rr < 2; ++rr) {
            const float dec = RET ? decR : T[256 + rr];
            bf16x8 kw[4];
#pragma unroll
            for (int ks = 0; ks < 4; ++ks) { float w[8];
                if (RET) {
#pragma unroll
                    for (int j = 0; j < 8; ++j) w[j] = wb[ks] * wj[j];
                } else { const f32x4 w0 = *(const LAS f32x4*)(T + rr * 128 + 32 * ks + 8 * g4), w1 = *(const LAS f32x4*)(T + rr * 128 + 32 * ks + 8 * g4 + 4);
                    w[0] = w0.x; w[1] = w0.y; w[2] = w0.z; w[3] = w0.w; w[4] = w1.x; w[5] = w1.y; w[6] = w1.z; w[7] = w1.w; }
                const v4u kv = __builtin_bit_cast(v4u, kf[ks]);
                kw[ks] = __builtin_bit_cast(bf16x8, (v4u){pk2(bflo(kv.x) * w[0], bfhi(kv.x) * w[1]), pk2(bflo(kv.y) * w[2], bfhi(kv.y) * w[3]), pk2(bflo(kv.z) * w[4], bfhi(kv.z) * w[5]), pk2(bflo(kv.w) * w[6], bfhi(kv.w) * w[7])}); }
#pragma unroll
            for (int pt = 0; pt < 4; ++pt) {
                f32x4 d = acc[rr][pt] * dec;
                LAS unsigned char* base = xb0 + 8 * (p4 & 1); const int cc = rr * 4 + pt;
#pragma unroll
                for (int ks = 0; ks < 4; ++ks) {
                    const s4v lo = tr_rd(base + img_off(32 * ks + 8 * g4 + q4, 2 * cc + (p4 >> 1))), hi = tr_rd(base + img_off(32 * ks + 8 * g4 + 4 + q4, 2 * cc + (p4 >> 1)));
                    d = MFMA16(kw[ks], mk8(lo, hi), d); }
                acc[rr][pt] = d; if (pt & 1) asm volatile("" ::: "memory"); }
        }
        if (!RET && c < 15 && tid < 258) TBL[((c + 1) & 1) * 512 + tid] = tvn;
        if (c < 14) asm volatile("s_waitcnt vmcnt(12)" ::: "memory"); else asm volatile("s_waitcnt vmcnt(0)" ::: "memory");
        asm volatile("s_waitcnt lgkmcnt(0)" ::: "memory");
        __builtin_amdgcn_s_barrier(); asm volatile("" ::: "memory");
    }
#undef SC_STAGE_K
#undef SC_STAGE_X
#undef SC_TBLVAL
    float* so = a.out + (RET ? O_RETP + ((size_t)(b * RH + gi) * RDV + rp * 128) * RDK + nh * 128 : O_SSMP + ((size_t)(b * NH + gi * 8 + 2 * rp) * 64) * NST) + 16 * wave + 4 * gs;
#pragma unroll
    for (int rr = 0; rr < 2; ++rr)
#pragma unroll
        for (int pt = 0; pt < 4; ++pt) *(f32x4*)(so + (size_t)(rr * 64 + 16 * pt + l15) * N) = acc[rr][pt];
}
__device__ __forceinline__ void scan_phase(const Args& a, LAS unsigned char* lds, int tid, int wave, int lane) {
    const int G = gridDim.x, vcu = (G % 8 == 0) ? (int)(blockIdx.x % 8) * (G / 8) + (int)(blockIdx.x / 8) : (int)blockIdx.x;
    for (int u = vcu; u < 256; u += G) scan_unit<true>(a, lds, u >> 6, (u >> 3) & 7, (u >> 1) & 3, u & 1, tid, wave, lane);
    for (int u = (vcu + 128) % G; u < 128; u += G) scan_unit<false>(a, lds, u >> 5, (u >> 2) & 7, u & 3, 0, tid, wave, lane);
}

template <bool RET> __device__ __forceinline__ void samp_stream(const Args& a, LAS unsigned char* lds, int tid, int wave, int lane, const int u0, const int ustride, const int nu) {
    constexpr int N = RET ? 256 : 128, NKS = N / 32, NSUB = N / 128, NTC = 2;
    constexpr int TSET = 28672;
    const bf16* PROJ = (const bf16*)(a.ws + WS_PROJ); const bf16* XBCA = (const bf16*)(a.ws + WS_XBCA);
    const float* DTV = (const float*)(a.ws + WS_DTV); const float* LA = (const float*)(a.ws + WS_LA);
    const bf16* Kb_ = RET ? PROJ : XBCA; const int nct = RET ? NCT_P : NCT_X;
    LAS float* SQ = (LAS float*)(lds + 2 * TSET); LAS float* YL = (LAS float*)(lds + 2 * TSET + 1024);
    const int g4 = lane >> 4, l15 = lane & 15, tt = l15 & 3;
    f32x4 cur[8], nxt[8];
    v4u tr[NTC]; float wv = 0.f;
#define TLOAD(bs_, gi_) do { const int Rs_ = NPR + (bs_) * SL; \
        _Pragma("unroll") for (int q_ = 0; q_ < NTC; ++q_) { const int k_ = tid + 512 * q_; int t_, col_; const bf16* src_ = Kb_; int nc_ = nct; \
            if (RET) { if (k_ < 128) { t_ = k_ >> 5; col_ = C_K + (gi_) * 256 + (k_ & 31) * 8; } else if (k_ < 256) { t_ = (k_ - 128) >> 5; col_ = C_Q + (gi_) * 256 + (k_ & 31) * 8; } else if (k_ < 512) { t_ = (k_ - 256) >> 6; col_ = C_V + (gi_) * 512 + (k_ & 63) * 8; } else { const int kk_ = k_ < 768 ? k_ - 512 : 0; t_ = kk_ >> 6; col_ = C_G + (gi_) * 512 + (kk_ & 63) * 8; } } \
            else { if (k_ < 64) { t_ = k_ >> 4; col_ = INNER + (gi_) * 128 + (k_ & 15) * 8; } else if (k_ < 128) { t_ = (k_ - 64) >> 4; col_ = INNER + NG * NST + (gi_) * 128 + (k_ & 15) * 8; } \
                   else if (k_ < 384) { t_ = (k_ - 128) >> 6; col_ = (gi_) * 512 + ((k_ - 128) & 63) * 8; } else { const int kk_ = k_ < 640 ? k_ - 384 : 0; t_ = kk_ >> 6; col_ = C_Z + (gi_) * 512 + (kk_ & 63) * 8; src_ = PROJ; nc_ = NCT_P; } } \
            tr[q_] = *(const v4u*)(src_ + toff(Rs_ + t_, col_, nc_)); } \
        if (lane < 8) { if (RET) wv = lane < 4 ? (float)(lane + 1) * logf(1.0f - exp2f(-5.0f - (float)(gi_))) : 1.0f; \
            else { const int h_ = (gi_) * 8 + wave; if (lane < 4) { wv = 0.f; for (int t2 = 0; t2 <= lane; ++t2) wv += LA[(size_t)(Rs_ + t2) * NH + h_]; } else wv = DTV[(size_t)(Rs_ + lane - 4) * NH + h_]; } } } while (0)
#define TWRITE(ts_) do { LAS unsigned char* tb_ = lds + (ts_) * TSET; \
        _Pragma("unroll") for (int q_ = 0; q_ < NTC; ++q_) { const int k_ = tid + 512 * q_; int off_ = -1; \
            if (RET) { if (k_ < 128) off_ = k_ * 32; else if (k_ < 256) off_ = 4096 + (k_ - 128) * 32; else if (k_ < 512) off_ = 8192 + (k_ - 256) * 32; else if (k_ < 768) off_ = 16384 + (k_ - 512) * 32; } \
            else { if (k_ < 64) off_ = k_ * 32; else if (k_ < 128) off_ = 4096 + (k_ - 64) * 32; else if (k_ < 384) off_ = 8192 + (k_ - 128) * 32; else if (k_ < 640) off_ = 16384 + (k_ - 384) * 32; } \
            if (off_ >= 0) { const v4u v_ = tr[q_]; *(LAS f32x4*)(tb_ + off_) = (f32x4){bflo(v_.x), bfhi(v_.x), bflo(v_.y), bfhi(v_.y)}; *(LAS f32x4*)(tb_ + off_ + 16) = (f32x4){bflo(v_.z), bfhi(v_.z), bflo(v_.w), bfhi(v_.w)}; } } \
        if (lane < 8) ((LAS float*)(tb_ + 24832))[wave * 8 + lane] = wv; } while (0)
#define SIN_OF(bs_, gi_) ((RET ? a.in[I_SRET] : a.in[I_SSSM]) + (RET ? ((size_t)((bs_) * RH + (gi_)) * RDV + wave * 64) : ((size_t)((bs_) * NH + (gi_) * 8 + wave) * 64)) * N)
#define SLOAD(dst, Sin_, j) do { const float* sp_ = (Sin_) + (size_t)(((j) / NSUB) * 16 + l15) * N + ((j) % NSUB) * 128 + 4 * g4; \
        _Pragma("unroll") for (int k_ = 0; k_ < 4; ++k_) { dst[2 * k_] = *(const f32x4*)(sp_ + 32 * k_); dst[2 * k_ + 1] = *(const f32x4*)(sp_ + 32 * k_ + 16); } } while (0)
    if (nu == 0) return;
    __syncthreads();
    { TLOAD(u0 >> 3, u0 & 7); TWRITE(0); SLOAD(cur, SIN_OF(u0 >> 3, u0 & 7), 0); }
    __syncthreads();
#pragma unroll 1
    for (int i = 0; i < nu; ++i) {
        const int u = u0 + i * ustride, bs = u >> 3, gi = u & 7, un = u + ustride, bsn = un >> 3, gin = un & 7; const bool more = i + 1 < nu;
        const size_t Rs = (size_t)NPR + (size_t)bs * SL;
        LAS unsigned char* tb = lds + (i & 1) * TSET;
        LAS float* BT = (LAS float*)tb; LAS float* CR = (LAS float*)(tb + 4096); LAS float* XT = (LAS float*)(tb + 8192); LAS float* ZT = (LAS float*)(tb + 16384);
        LAS float* CB = (LAS float*)(tb + 24576); LAS float* WSC = (LAS float*)(tb + 24832);
        const float* Sin = SIN_OF(bs, gi); float* Sout = a.out + (RET ? O_RETS : O_SSMS) + (Sin - (RET ? a.in[I_SRET] : a.in[I_SSSM]));
        for (int pp = wave; pp < 16; pp += 8) { const int t = pp >> 2, s = pp & 3; float d = 0.f; for (int n = lane; n < N; n += 64) d += CR[t * N + n] * BT[s * N + n]; d = wave_sum(d); if (lane == 0) CB[pp] = d; }
        __syncthreads();
        if (more) TLOAD(bsn, gin);
        const float acs_t = WSC[wave * 8 + tt], acs3 = WSC[wave * 8 + 3], A3 = __expf(acs3), At = __expf(acs_t);
        float cf[4], wd[4];
#pragma unroll
        for (int s = 0; s < 4; ++s) { const float as = WSC[wave * 8 + s], ds = WSC[wave * 8 + 4 + s]; cf[s] = (s <= tt) ? __expf(acs_t - as) * ds * CB[tt * 4 + s] : 0.f; wd[s] = __expf(acs3 - as) * ds; }
        const float Dh = RET ? 0.f : a.in[I_DSKIP][gi * 8 + wave];
        bf16x8 qf[NKS];
#pragma unroll
        for (int ks = 0; ks < NKS; ++ks) { const f32x4 c0 = *(const LAS f32x4*)(CR + tt * N + 32 * ks + 4 * g4), c1 = *(const LAS f32x4*)(CR + tt * N + 32 * ks + 16 + 4 * g4);
            const float m = l15 < 4 ? At : 0.f;
            qf[ks] = __builtin_bit_cast(bf16x8, (v4u){pk2(c0.x * m, c0.y * m), pk2(c0.z * m, c0.w * m), pk2(c1.x * m, c1.y * m), pk2(c1.z * m, c1.w * m)}); }
        float ssq = 0.f; f32x4 acc = (f32x4){0.f, 0.f, 0.f, 0.f};
#define SAMP_SUB(st, j) do { const int slab_ = (j) / NSUB, sub_ = (j) % NSUB, pu_ = 64 * wave + 16 * slab_; \
        float u_[4]; _Pragma("unroll") for (int s = 0; s < 4; ++s) u_[s] = wd[s] * XT[s * 512 + pu_ + l15]; \
        float* op_ = Sout + (size_t)(slab_ * 16 + l15) * N + sub_ * 128 + 4 * g4; \
        _Pragma("unroll") for (int k = 0; k < 4; ++k) { \
            const f32x4 s0 = st[2 * k], s1 = st[2 * k + 1]; \
            const bf16x8 af = __builtin_bit_cast(bf16x8, (v4u){pk2(s0.x, s0.y), pk2(s0.z, s0.w), pk2(s1.x, s1.y), pk2(s1.z, s1.w)}); \
            acc = MFMA16(af, (NSUB == 1 || sub_ == 0) ? qf[k] : qf[(NKS - 4) + k], acc); \
            f32x4 n0 = s0 * A3, n1 = s1 * A3; \
            _Pragma("unroll") for (int s = 0; s < 4; ++s) { const f32x4 b0 = *(const LAS f32x4*)(BT + s * N + sub_ * 128 + 32 * k + 4 * g4), b1 = *(const LAS f32x4*)(BT + s * N + sub_ * 128 + 32 * k + 16 + 4 * g4); \
                n0 += b0 * u_[s]; n1 += b1 * u_[s]; } \
            *(f32x4*)(op_ + 32 * k) = n0; *(f32x4*)(op_ + 32 * k + 16) = n1; } \
        if (sub_ == NSUB - 1) { \
            _Pragma("unroll") for (int i = 0; i < 4; ++i) { const int pc = pu_ + 4 * g4 + i; \
                float y = acc[i] + cf[0] * XT[pc] + cf[1] * XT[512 + pc] + cf[2] * XT[1024 + pc] + cf[3] * XT[1536 + pc]; \
                if (!RET) { y += Dh * XT[tt * 512 + pc]; const float z = ZT[tt * 512 + pc]; y *= siluf(z); } \
                if (l15 < 4) { YL[pc * 4 + tt] = y; ssq += y * y; } } \
            acc = (f32x4){0.f, 0.f, 0.f, 0.f}; } } while (0)
#pragma unroll 1
        for (int jp = 0; jp < 2 * NSUB; ++jp) {
            SLOAD(nxt, Sin, 2 * jp + 1);
            SAMP_SUB(cur, 2 * jp);
            if (jp + 1 < 2 * NSUB) SLOAD(cur, Sin, 2 * jp + 2);
            SAMP_SUB(nxt, 2 * jp + 1);
        }
        if (more) { SLOAD(cur, SIN_OF(bsn, gin), 0); TWRITE((i + 1) & 1); }
#undef SAMP_SUB
        ssq += __shfl_xor(ssq, 16); ssq += __shfl_xor(ssq, 32);
        if (lane < 4) SQ[wave * 4 + lane] = ssq;
        __syncthreads();
        float tot = 0.f;
#pragma unroll
        for (int w = 0; w < 8; ++w) tot += SQ[w * 4 + tt];
        const float rstd = 1.0f / sqrtf(tot * (1.0f / 512.0f) + EPS);
        if (wave == 0 && lane < 4) ((float*)(a.ws + WS_RSTD))[(Rs + lane) * 16 + (RET ? 8 : 0) + gi] = 1.0f;
        if (l15 < 4) {
            bf16* Yo = (bf16*)(a.ws + (RET ? WS_YR : WS_YS)) + (Rs + tt) * INNER + gi * 512;
#pragma unroll 1
            for (int slab = 0; slab < 4; ++slab) { const int pc = 64 * wave + 16 * slab + 4 * g4; float o[4];
#pragma unroll
                for (int i2 = 0; i2 < 4; ++i2) { o[i2] = YL[(pc + i2) * 4 + tt] * rstd;
                    if (RET) o[i2] *= siluf(ZT[tt * 512 + pc + i2]); else o[i2] *= a.in[I_SNW][gi * 512 + pc + i2]; }
                v2u ov; ov.x = pk2(o[0], o[1]); ov.y = pk2(o[2], o[3]); *(v2u*)(Yo + pc) = ov; }
        }
        __syncthreads();
    }
#undef TLOAD
#undef TWRITE
#undef SIN_OF
#undef SLOAD
}
__device__ __forceinline__ void scan_samp_phase(const Args& a, LAS unsigned char* lds, int tid, int wave, int lane) {
    const int G = gridDim.x;
    scan_phase(a, lds, tid, wave, lane);
    if (G == 256) {
        const int vcu = (int)(blockIdx.x % 8) * 32 + (int)(blockIdx.x / 8);
        samp_stream<true>(a, lds, tid, wave, lane, (int)blockIdx.x, G, 4);
        if (vcu < 128) samp_stream<false>(a, lds, tid, wave, lane, vcu, 128, 5); else samp_stream<false>(a, lds, tid, wave, lane, 640 + (vcu - 128), 128, 3);
    } else {
        const int nu = ((int)blockIdx.x < SB * 8) ? (SB * 8 - 1 - (int)blockIdx.x) / G + 1 : 0;
        samp_stream<true>(a, lds, tid, wave, lane, (int)blockIdx.x, G, nu); samp_stream<false>(a, lds, tid, wave, lane, (int)blockIdx.x, G, nu);
    }
}

#ifndef PROBE_DUP
#define PROBE_DUP 0
#endif
#ifndef MK_N_LAUNCHES
#define MK_N_LAUNCHES 1
#endif
constexpr int N_PHASES = 9;
template <int LO, int HI> __global__ void __launch_bounds__(NWAVES * 64, 2) fwd_kernel(Args args) {
    extern __shared__ __attribute__((aligned(16))) unsigned char lds_raw[];
    LAS unsigned char* lds = (LAS unsigned char*)lds_raw;
    const int tid = threadIdx.x, lane = tid & 63, wave = __builtin_amdgcn_readfirstlane(tid >> 6);
    const int G = gridDim.x;
    for (int u = tid; u < (LDS_BYTES - LDSCTL_OFF) / 4; u += NWAVES * 64) ((LAS unsigned*)(lds + LDSCTL_OFF))[u] = 0u;
    __syncthreads();
    unsigned* ctl = (unsigned*)(args.ws + WS_CTL);
    XcdBarrier bar; bar.bar = ctl + CW_BAR; bar.x = 0; bar.st = nullptr;
    constexpr int lo = LO, hi = HI;
    if (hi - lo > 1) bar = xcd_barrier_post(ctl + CW_BAR, (volatile LAS unsigned*)(lds + MISC_OFF) + 8);
#define IN(k) (lo <= (k) && (k) < hi)
#define IF_IN(k) if constexpr (IN(k))
#define SEAM(k) do { if constexpr (IN(k) && IN((k) + 1)) xcd_barrier(bar); } while (0)

#define PH_0 p0_prologue(args, lds, wave, lane)
#define PH_1 do { pg8::Gemm g{(const bf16*)(args.ws + WS_HN), (const bf16*)(args.ws + WS_WTIN), MT, LDP, DM, nullptr, nullptr}; pg8::StaticOrder S; S.init(MT, LDP, DM, G, (int)blockIdx.x); \
        pg8::EpiProj E{(bf16*)(args.ws + WS_PROJ), (float*)(args.ws + WS_DT), LDP, DT_TILE, (const float*)(args.ws + WS_COS), (const float*)(args.ws + WS_SIN), C_Q / 256, C_K / 256, NPR}; \
        pg8::gemm_phase<pg8::EpiProj, pg8::StaticOrder, true, true>(lds + RING_OFF, g, S, E); } while (0)
#define PH_2 p2_prep(args, lds)
#define PH_3 scan_samp_phase(args, lds, tid, wave, lane)
#define PH_4 passC(args.ws, args.in[I_DSKIP], args.in[I_SNW], lds)
#define PH_5 do { pg8::Gemm g{(const bf16*)(args.ws + WS_YS), (const bf16*)(args.ws + WS_WTPS), MT, DM, INNER, (const bf16*)(args.ws + WS_YR), (const bf16*)(args.ws + WS_WTPR)}; pg8::DualOrder S{G, (int)blockIdx.x}; \
        pg8::EpiDual E{(const bf16*)(args.ws + WS_PROJ), LDP, C_GATE, (bf16*)(args.ws + WS_MG), (float*)(args.ws + WS_MFS), NPR / 256, (const float*)(args.ws + WS_RSTD)}; \
        pg8::gemm_phase<pg8::EpiDual, pg8::DualOrder, true, true>(lds + RING_OFF, g, S, E); } while (0)
#define PH_6 p7_merge_sample(args)
#define PH_7 do { pg8::Gemm g{(const bf16*)(args.ws + WS_MG), (const bf16*)(args.ws + WS_WTO), MT, DM, DM, nullptr, nullptr}; pg8::OutOrder S{G, (int)blockIdx.x}; \
        pg8::EpiOut2 E{(float*)(args.ws + WS_OF), (float*)(args.ws + WS_OFS), NPR / 256}; \
        pg8::gemm_phase<pg8::EpiOut2, pg8::OutOrder, true, true>(lds + RING_OFF, g, S, E); } while (0)
#define PH_8 p8_final(args, wave, lane)
#ifndef SKIPMASK
#define SKIPMASK 0
#endif
#define RUN(k) do { IF_IN(k) { if constexpr (!(((SKIPMASK) >> (k)) & 1)) PH_##k; if constexpr ((MK_N_LAUNCHES == 1) && (((PROBE_DUP) >> (k)) & 1)) { xcd_barrier(bar); PH_##k; } } SEAM(k); } while (0)
    RUN(0); RUN(1); RUN(2); RUN(3); RUN(4); RUN(5); RUN(6); RUN(7); RUN(8);
#undef RUN
#undef IN
#undef IF_IN
#undef SEAM
}

template <int LO, int HI> static bool setup_one() { return hipFuncSetAttribute((const void*)fwd_kernel<LO, HI>, hipFuncAttributeMaxDynamicSharedMemorySize, LDS_BYTES) == hipSuccess; }
template <int LO, int HI> static void launch_one(int grid, hipStream_t stream, const Args& a) { hipLaunchKernelGGL((fwd_kernel<LO, HI>), dim3(grid), dim3(NWAVES * 64), LDS_BYTES, stream, a); }
#if MK_N_LAUNCHES == 1
static bool setup_all() { return setup_one<0, N_PHASES>(); }
static void launch_all(int grid, hipStream_t stream, const Args& a) { launch_one<0, N_PHASES>(grid, stream, a); }
#else
static bool setup_all() { return setup_one<0, 1>() && setup_one<1, 2>() && setup_one<2, 3>() && setup_one<3, 4>() && setup_one<4, 5>() && setup_one<5, 6>() && setup_one<6, 7>() && setup_one<7, 8>() && setup_one<8, 9>(); }
template <int K> static void launch_ph(int grid, hipStream_t stream, const Args& a) { launch_one<K, K + 1>(grid, stream, a); if ((PROBE_DUP >> K) & 1) launch_one<K, K + 1>(grid, stream, a); }
static void launch_all(int grid, hipStream_t stream, const Args& a) {
    launch_ph<0>(grid, stream, a); launch_ph<1>(grid, stream, a); launch_ph<2>(grid, stream, a); launch_ph<3>(grid, stream, a); launch_ph<4>(grid, stream, a);
    launch_ph<5>(grid, stream, a); launch_ph<6>(grid, stream, a); launch_ph<7>(grid, stream, a); launch_ph<8>(grid, stream, a); }
#endif
extern "C" void kernel_launch(void* const* d_in, const int* in_sizes, int n_in, void* d_out, int out_size, void* d_ws, size_t ws_size, hipStream_t stream) {
    static int grid = 0;
    if (grid == 0) {
        if (n_in != 17 || (size_t)out_size != O_END || ws_size < WS_END) { fprintf(stderr, "kernel_launch: unexpected shapes (n_in %d out %d ws %zu); nothing launched\n", n_in, out_size, ws_size); grid = -1; return; }
        int dev = 0, cus = 0, per_cu = 0;
        if (hipGetDevice(&dev) != hipSuccess || hipDeviceGetAttribute(&cus, hipDeviceAttributeMultiprocessorCount, dev) != hipSuccess) { grid = -1; return; }
        if (!setup_all()) { fprintf(stderr, "kernel_launch: hipFuncSetAttribute failed\n"); grid = -1; return; }
        (void)per_cu; (void)hipGetLastError();
        grid = cus;
    }
    if (grid < 0) return;
    if (hipMemsetAsync((char*)d_ws + WS_CTL, 0, CTL_ZERO_BYTES, stream) != hipSuccess) return;
    Args a{};
    for (int i = 0; i < 17; ++i) a.in[i] = (const float*)d_in[i];
    a.out = (float*)d_out; a.ws = (unsigned char*)d_ws;
    static_assert(sizeof(Args) == 160, "Args has no padding");
    a.ph_lo = 0; a.ph_hi = N_PHASES;
    launch_all(grid, stream, a);
}
#ifdef TEST_LO
template __global__ void fwd_kernel<TEST_LO, TEST_HI>(Args);
#endif
```

```cpp
#include <hip/hip_runtime.h>
#include <cstdio>
#include <cstdint>
namespace pg8 {
#define PG8_LAS __attribute__((address_space(3)))
typedef unsigned short bf16_t;
typedef short bf16x8 __attribute__((ext_vector_type(8)));
typedef float f32x4 __attribute__((ext_vector_type(4)));
typedef unsigned u32x4 __attribute__((ext_vector_type(4)));
constexpr int BM = 256, BK = 64, HALF = 128, HTB = HALF * BK * 2  , STAGE_BYTES = 8 * HTB, NXCD = 8, WGM = 8;

__host__ __device__ __forceinline__ int lds_byte(int r, int c) { const int st = (r >> 4) * 2 + (c >> 5), rr = r & 15, cc = c & 31, ob = rr * 64 + cc * 2; return st * 1024 + (ob ^ (((ob >> 9) & 1) << 5)); }
__host__ __device__ __forceinline__ void stage_rc(int b, int& R, int& C) { const int st = b / 1024, sb = b % 1024, swz = sb ^ (((sb >> 9) & 1) << 5); R = (st >> 1) * 16 + swz / 64; C = (st & 1) * 32 + (swz % 64) / 2; }
__host__ __device__ __forceinline__ int perm32(int rho) { const int n = rho >> 4, i = rho & 15; return 8 * (i >> 2) + 4 * n + (i & 3); }

struct Unit { int pm, pn, sel, k0, nt, mode; };
struct Gemm { const bf16_t* A; const bf16_t* Bt; int M, N, K; const bf16_t* A2; const bf16_t* Bt2; };

struct StaticOrder {
    int nM, nN, nwg, G, c, ntk;
    __host__ __device__ void init(int M, int N, int K, int G_, int c_) { nM = M / BM; nN = N / BM; nwg = nM * nN; G = G_; c = c_; ntk = K / BK; }
    __host__ __device__ bool next(int i, Unit& u) const {
        const long L = (long)i * G + c; if (L >= nwg) return false;
        int wgid = (int)L; { const int q = nwg / NXCD, r = nwg % NXCD, xcd = wgid % NXCD, off = wgid / NXCD; wgid = (xcd < r ? xcd * (q + 1) : r * (q + 1) + (xcd - r) * q) + off; }
        const int nig = WGM * nN, gid = wgid / nig, fm = gid * WGM, gsz = (nM - fm) < WGM ? (nM - fm) : WGM;
        u.pm = fm + ((wgid % nig) % gsz); u.pn = (wgid % nig) / gsz; u.sel = 0; u.k0 = 0; u.nt = ntk; u.mode = 0; return true;
    }
    __device__ __forceinline__ void a_ready(const Unit&) const {}
    __device__ __forceinline__ void done(const Unit&) const {}
};

__device__ __forceinline__ unsigned cvt_pk_bf16(float lo, float hi) { unsigned r; asm volatile("v_cvt_pk_bf16_f32 %0, %1, %2" : "=v"(r) : "v"(lo), "v"(hi)); return r; }
typedef float f32x2 __attribute__((ext_vector_type(2)));

constexpr int PROJ_NCT = 210;
__device__ __forceinline__ size_t toff(int row, int col, int nct) { return ((size_t)(row >> 7) * nct + (col >> 7)) * 16384 + (size_t)(row & 127) * 128 + (col & 127); }
__device__ __forceinline__ float bf_lo(unsigned w) { return __uint_as_float(w << 16); }
__device__ __forceinline__ float bf_hi(unsigned w) { return __uint_as_float(w & 0xffff0000u); }
__device__ __forceinline__ float sigmoidf_(float x) { return __builtin_amdgcn_rcpf(1.0f + __expf(-x)); }

struct EpiProj {
    static constexpr bool PERM = true, AFTER_DRAIN = false, HAS_MID = false;
    bf16_t* O; float* DT; int ldp; int dt_tile; const float* COS; const float* SIN; int qk_tile0, k_tile0, npr;
    __device__ __forceinline__ void operator()(const f32x4 (&acc)[2][2][4][2], const Unit& u, int wr, int wc, int fr, int fq) const {
        asm volatile("" : "+v"(fr), "+v"(fq));
        const int row0 = u.pm * BM + wr * 64 + fr; const unsigned lane_off = (unsigned)(fr * 256 + fq * 16);
        if (u.pn >= qk_tile0 && u.pn < qk_tile0 + 16) {
            const int col0 = u.pn * BM + wc * 32 + 8 * fq, ic = wc * 32 + 8 * fq; const float sc = u.pn >= k_tile0 ? 0.0625f : 1.0f;
#pragma unroll
            for (int ai = 0; ai < 2; ++ai)
#pragma unroll
                for (int m = 0; m < 4; ++m) { const int row = row0 + ai * HALF + m * 16, pidx = row < npr ? (row & 2047) : 2048 + (row & 3);
                    char* tb = (char*)O + (((size_t)(2 * u.pm + ai) * PROJ_NCT + 2 * u.pn) * 16384 + (wr * 64 + m * 16) * 128 + wc * 32) * 2 + lane_off;
                    const f32x4 c0 = *(const f32x4*)(COS + pidx * 128 + ic), c1 = *(const f32x4*)(COS + pidx * 128 + ic + 4), s0 = *(const f32x4*)(SIN + pidx * 128 + ic), s1 = *(const f32x4*)(SIN + pidx * 128 + ic + 4);
                    const f32x4 a0 = acc[ai][0][m][0], a1 = acc[ai][0][m][1], b0 = acc[ai][1][m][0], b1 = acc[ai][1][m][1];
                    const f32x4 o0 = (a0 * c0 - b0 * s0) * sc, o1 = (a1 * c1 - b1 * s1) * sc, p0 = (b0 * c0 + a0 * s0) * sc, p1 = (b1 * c1 + a1 * s1) * sc;
                    u32x4 w; w.x = cvt_pk_bf16(o0[0], o0[1]); w.y = cvt_pk_bf16(o0[2], o0[3]); w.z = cvt_pk_bf16(o1[0], o1[1]); w.w = cvt_pk_bf16(o1[2], o1[3]);
                    *(u32x4*)tb = w;
                    w.x = cvt_pk_bf16(p0[0], p0[1]); w.y = cvt_pk_bf16(p0[2], p0[3]); w.z = cvt_pk_bf16(p1[0], p1[1]); w.w = cvt_pk_bf16(p1[2], p1[3]);
                    *(u32x4*)(tb + 32768) = w;
                    asm volatile("" ::: "memory"); }
        } else if (u.pn != dt_tile) {
            const int col0 = u.pn * BM + wc * 32 + 8 * fq;
#pragma unroll
            for (int ai = 0; ai < 2; ++ai)
#pragma unroll
                for (int m = 0; m < 4; ++m) { char* tb = (char*)O + (((size_t)(2 * u.pm + ai) * PROJ_NCT + 2 * u.pn) * 16384 + (wr * 64 + m * 16) * 128 + wc * 32) * 2 + lane_off;
#pragma unroll
                    for (int bj = 0; bj < 2; ++bj) { const f32x4 v0 = acc[ai][bj][m][0], v1 = acc[ai][bj][m][1];
                        u32x4 w; w.x = cvt_pk_bf16(v0[0], v0[1]); w.y = cvt_pk_bf16(v0[2], v0[3]); w.z = cvt_pk_bf16(v1[0], v1[1]); w.w = cvt_pk_bf16(v1[2], v1[3]);
                        *(u32x4*)(tb + bj * 32768) = w; }
                    asm volatile("" ::: "memory"); }
        } else if (wc < 2) {
#pragma unroll
            for (int ai = 0; ai < 2; ++ai)
#pragma unroll
                for (int m = 0; m < 4; ++m) { float* rp = DT + (size_t)(row0 + ai * HALF + m * 16) * 64 + wc * 32 + 8 * fq;
                    *(f32x4*)rp = acc[ai][0][m][0]; *(f32x4*)(rp + 4) = acc[ai][0][m][1]; }
        }
    }
};
struct EpiDual {
    static constexpr bool PERM = true, AFTER_DRAIN = false, HAS_MID = true;
    const bf16_t* gate; int ldg; int gcol; bf16_t* MG; float* MFS; int prompt_panels; const float* RS;
    __device__ __forceinline__ void pre(float (&pr)[16], const Unit& u, int wr, int fr) const {
        const int row0 = u.pm * BM + wr * 64 + fr, j = u.sel * 8 + (u.k0 >> 9);
#pragma unroll
        for (int ai = 0; ai < 2; ++ai)
#pragma unroll
            for (int m = 0; m < 4; ++m) { const float* rp = RS + (size_t)(row0 + ai * HALF + m * 16) * 16 + j; pr[2 * (ai * 4 + m)] = rp[0]; pr[2 * (ai * 4 + m) + 1] = rp[1]; }
    }
    __device__ __forceinline__ void mid(f32x4 (&acc)[2][2][4][2], const Unit& u, const float (&pr)[16], int wr, int wc, int fr, int fq) const {
        asm volatile("" : "+v"(fr), "+v"(fq));
        const int row0 = u.pm * BM + wr * 64 + fr, col0 = u.pn * BM + wc * 32 + 8 * fq, j = u.sel * 8 + (u.k0 >> 9);
        if (j == 7) {
#pragma unroll
            for (int ai = 0; ai < 2; ++ai)
#pragma unroll
                for (int m = 0; m < 4; ++m) {
#pragma unroll
                    for (int bj = 0; bj < 2; ++bj) { const int c = col0 + bj * HALF;
                        const bf16_t* gp = gate + ((size_t)(2 * u.pm + ai) * PROJ_NCT + ((gcol + c) >> 7)) * 16384 + (wr * 64 + m * 16 + fr) * 128 + wc * 32 + 8 * fq;
                        const u32x4 g1 = *(const u32x4*)gp, g2 = *(const u32x4*)(gp + 16 * 16384);
#define RAT_(a, b) ((1.0f + __expf(-(b))) * __builtin_amdgcn_rcpf(1.0f + __expf(-(a))))
                        f32x4& v0 = acc[ai][bj][m][0]; f32x4& v1 = acc[ai][bj][m][1];
                        v0[0] *= RAT_(bf_lo(g1.x), bf_lo(g2.x)); v0[1] *= RAT_(bf_hi(g1.x), bf_hi(g2.x)); v0[2] *= RAT_(bf_lo(g1.y), bf_lo(g2.y)); v0[3] *= RAT_(bf_hi(g1.y), bf_hi(g2.y));
                        v1[0] *= RAT_(bf_lo(g1.z), bf_lo(g2.z)); v1[1] *= RAT_(bf_hi(g1.z), bf_hi(g2.z)); v1[2] *= RAT_(bf_lo(g1.w), bf_lo(g2.w)); v1[3] *= RAT_(bf_hi(g1.w), bf_hi(g2.w));
#undef RAT_
                    }
                    asm volatile("" ::: "memory"); }
        }
#pragma unroll
        for (int ai = 0; ai < 2; ++ai)
#pragma unroll
            for (int m = 0; m < 4; ++m) { const float rr = pr[2 * (ai * 4 + m)] * __builtin_amdgcn_rcpf(pr[2 * (ai * 4 + m) + 1]);
#pragma unroll
                for (int bj = 0; bj < 2; ++bj) { acc[ai][bj][m][0] *= rr; acc[ai][bj][m][1] *= rr; } }
        (void)row0;
    }
    __device__ __forceinline__ void operator()(const f32x4 (&acc)[2][2][4][2], const Unit& u, int wr, int wc, int fr, int fq) const {
        asm volatile("" : "+v"(fr), "+v"(fq));
        const int row0 = u.pm * BM + wr * 64 + fr, col0 = u.pn * BM + wc * 32 + 8 * fq;
        const bool prompt = u.pm < prompt_panels; const int gc = gcol + ((prompt || u.sel) ? 2048 : 0);
#pragma unroll
        for (int ai = 0; ai < 2; ++ai)
#pragma unroll
            for (int m = 0; m < 4; ++m) { const size_t r = (size_t)(row0 + ai * HALF + m * 16);
#pragma unroll
                for (int bj = 0; bj < 2; ++bj) { const int c = col0 + bj * HALF;
                    const u32x4 gw = *(const u32x4*)(gate + ((size_t)(2 * u.pm + ai) * PROJ_NCT + ((gc + c) >> 7)) * 16384 + (wr * 64 + m * 16 + fr) * 128 + wc * 32 + 8 * fq);
                    const float rl = prompt ? RS[r * 16 + 15] : 1.0f;
                    const f32x4 v0 = acc[ai][bj][m][0] * rl, v1 = acc[ai][bj][m][1] * rl;
                    f32x4 o0, o1;
                    o0[0] = v0[0] * sigmoidf_(bf_lo(gw.x)); o0[1] = v0[1] * sigmoidf_(bf_hi(gw.x)); o0[2] = v0[2] * sigmoidf_(bf_lo(gw.y)); o0[3] = v0[3] * sigmoidf_(bf_hi(gw.y));
                    o1[0] = v1[0] * sigmoidf_(bf_lo(gw.z)); o1[1] = v1[1] * sigmoidf_(bf_hi(gw.z)); o1[2] = v1[2] * sigmoidf_(bf_lo(gw.w)); o1[3] = v1[3] * sigmoidf_(bf_hi(gw.w));
                    if (prompt) { u32x4 w; w.x = cvt_pk_bf16(o0[0], o0[1]); w.y = cvt_pk_bf16(o0[2], o0[3]); w.z = cvt_pk_bf16(o1[0], o1[1]); w.w = cvt_pk_bf16(o1[2], o1[3]);
                        *(u32x4*)(MG + r * 2048 + c) = w; }
                    else { float* d = MFS + ((size_t)(u.sel * 8 + (u.k0 >> 9)) * 512 + (r - (size_t)prompt_panels * BM)) * 2048 + c;
                        *(f32x4*)d = o0; *(f32x4*)(d + 4) = o1; } }
                asm volatile("" ::: "memory"); }
    }
};
struct EpiOut2 {
    static constexpr bool PERM = true, AFTER_DRAIN = false, HAS_MID = false;
    float* OF; float* OFS; int prompt_panels;
    __device__ __forceinline__ void operator()(const f32x4 (&acc)[2][2][4][2], const Unit& u, int wr, int wc, int fr, int fq) const {
        asm volatile("" : "+v"(fr), "+v"(fq));
        const int row0 = u.pm * BM + wr * 64 + fr, col0 = u.pn * BM + wc * 32 + 8 * fq; const bool prompt = u.pm < prompt_panels;
#pragma unroll
        for (int ai = 0; ai < 2; ++ai)
#pragma unroll
            for (int m = 0; m < 4; ++m) { const size_t r = (size_t)(row0 + ai * HALF + m * 16);
                float* rp = prompt ? OF + r * 2048 + col0 : OFS + ((size_t)(u.k0 >> 8) * 512 + (r - (size_t)prompt_panels * BM)) * 2048 + col0;
#pragma unroll
                for (int bj = 0; bj < 2; ++bj) { *(f32x4*)(rp + bj * HALF) = acc[ai][bj][m][0]; *(f32x4*)(rp + bj * HALF + 4) = acc[ai][bj][m][1]; } }
    }
};
struct DualOrder {
    int G, c;
    __device__ __forceinline__ bool next(int i, Unit& u) const {
        const int nd = c < 256 ? (256 - c + G - 1) / G : 0;
        if (i < 16 * nd) { const int j = c + (i >> 4) * G, vj = (j & 7) * 32 + (j >> 3), q = i & 15;
            u.pm = vj >> 3; u.pn = vj & 7; u.sel = q >> 3; u.k0 = (q & 7) * 512; u.nt = 8; u.mode = (q == 15) ? 2 : 1; return true; }
        const int s = c + (i - 16 * nd) * G; if (s >= 256) return false;
        const int ks = s & 15; u.pm = 32 + (s >> 7); u.pn = (s >> 4) & 7; u.sel = ks >> 3; u.k0 = (ks & 7) * 512; u.nt = 8; u.mode = 0; return true;
    }
    __device__ __forceinline__ void a_ready(const Unit&) const {}
    __device__ __forceinline__ void done(const Unit&) const {}
};
struct OutOrder {
    int G, c;
    __device__ __forceinline__ bool next(int i, Unit& u) const {
        const int nd = c < 256 ? (256 - c + G - 1) / G : 0;
        if (i < nd) { const int j = c + i * G, vj = (j & 7) * 32 + (j >> 3); u.pm = vj >> 3; u.pn = vj & 7; u.sel = 0; u.k0 = 0; u.nt = 32; u.mode = 0; return true; }
        const int s = c + (i - nd) * G; if (s >= 128) return false;
        u.pm = 32 + (s >> 6); u.pn = (s >> 3) & 7; u.sel = 0; u.k0 = (s & 7) * 256; u.nt = 4; u.mode = 0; return true;
    }
    __device__ __forceinline__ void a_ready(const Unit&) const {}
    __device__ __forceinline__ void done(const Unit&) const {}
};
template <class Epi, class Sched, bool ALIGN_EPI = false, bool SP2 = false>
__device__ __forceinline__ void gemm_phase(PG8_LAS unsigned char* lds, const Gemm g, const Sched& S, const Epi& E) {
    const int tid = threadIdx.x, wid = __builtin_amdgcn_readfirstlane(tid >> 6), lane = tid & 63, wr = wid >> 2, wc = wid & 3, fr = lane & 15, fq = lane >> 4;
    const int K = g.K;
    unsigned voffA[2], voffB[2];
#pragma unroll
    for (int i = 0; i < 2; ++i) { int R, C; stage_rc(tid * 16 + i * 8192, R, C); const int Rb = Epi::PERM ? ((R & ~31) + perm32(R & 31)) : R;
        voffA[i] = (unsigned)(R * K + C) * 2u; voffB[i] = (unsigned)(Rb * K + C) * 2u; }
    const size_t kstep = (size_t)(BK * 2);
    const size_t hstep = (size_t)HALF * K * 2;
    const size_t tstep = 2 * hstep;
    const unsigned ldsw = (unsigned)wid * 1024u;
    const int aoff = lds_byte(wr * 64 + fr, fq * 8), boff = lds_byte(wc * 32 + fr, fq * 8);
#define PG8_SA(b, h) (((b) * 2 + (h)) * HTB)
#define PG8_SB(b, h) ((4 + (b) * 2 + (h)) * HTB)
#define PG8_STAGE(bufoff, gbase, voff) do { _Pragma("unroll") for (int _i = 0; _i < 2; ++_i) \
        __builtin_amdgcn_global_load_lds((const unsigned*)((const char*)(gbase) + (voff)[_i]), (PG8_LAS unsigned*)(lds + (bufoff) + ldsw + _i * 8192), 16, 0, 0); } while (0)
#define PG8_LDA(dst, b, h) do { _Pragma("unroll") for (int m = 0; m < 4; ++m) _Pragma("unroll") for (int k = 0; k < 2; ++k) dst[m][k] = *(const PG8_LAS bf16x8*)(lds + PG8_SA(b, h) + aoff + m * 2048 + k * 1024); } while (0)
#define PG8_LDB(dst, b, h) do { _Pragma("unroll") for (int n = 0; n < 2; ++n) _Pragma("unroll") for (int k = 0; k < 2; ++k) dst[n][k] = *(const PG8_LAS bf16x8*)(lds + PG8_SB(b, h) + boff + n * 2048 + k * 1024); } while (0)
#define PG8_MMA(ai, bj, At, Bt) do { __builtin_amdgcn_s_setprio(1); _Pragma("unroll") for (int m = 0; m < 4; ++m) _Pragma("unroll") for (int n = 0; n < 2; ++n) _Pragma("unroll") for (int k = 0; k < 2; ++k) \
        acc[ai][bj][m][n] = __builtin_amdgcn_mfma_f32_16x16x32_bf16(Bt[n][k], At[m][k], acc[ai][bj][m][n], 0, 0, 0); __builtin_amdgcn_s_setprio(0); } while (0)
#define PG8_WAIT_V(n) asm volatile("s_waitcnt vmcnt(" #n ")" ::: "memory")
#define PG8_WAIT_L(n) asm volatile("s_waitcnt lgkmcnt(" #n ")" ::: "memory")
#define PG8_BAR __builtin_amdgcn_s_barrier()
#define PG8_SCHED __builtin_amdgcn_sched_barrier(0)
    Unit cur, nxt; int ui = 0;
    if (!S.next(0, cur)) return;
    f32x4 acc[2][2][4][2];
#pragma unroll
    for (int a = 0; a < 2; ++a)
#pragma unroll
        for (int b = 0; b < 2; ++b)
#pragma unroll
            for (int m = 0; m < 4; ++m)
#pragma unroll
                for (int n = 0; n < 2; ++n) acc[a][b][m][n] = (f32x4){0.f, 0.f, 0.f, 0.f};
    bf16x8 At[4][2], B0[2][2], B1[2][2];
    const char* cA = (const char*)(cur.sel ? g.A2 : g.A) + (size_t)cur.pm * tstep + (size_t)cur.k0 * 2; const char* cB = (const char*)(cur.sel ? g.Bt2 : g.Bt) + (size_t)cur.pn * tstep + (size_t)cur.k0 * 2;
    S.a_ready(cur);
    if constexpr (SP2) {
        PG8_STAGE(PG8_SB(0, 0), cB, voffB); PG8_STAGE(PG8_SB(0, 1), cB + hstep, voffB); PG8_STAGE(PG8_SA(0, 0), cA, voffA); PG8_STAGE(PG8_SA(0, 1), cA + hstep, voffA);
        if (wr == 1) PG8_BAR;
        PG8_WAIT_V(2); PG8_BAR;
        PG8_STAGE(PG8_SB(1, 0), cB + kstep, voffB); PG8_STAGE(PG8_SA(1, 0), cA + kstep, voffA); PG8_STAGE(PG8_SB(1, 1), cB + hstep + kstep, voffB);
        PG8_WAIT_V(6); PG8_BAR;
    } else {
        PG8_STAGE(PG8_SB(0, 0), cB, voffB); PG8_STAGE(PG8_SA(0, 0), cA, voffA); PG8_STAGE(PG8_SB(0, 1), cB + hstep, voffB); PG8_STAGE(PG8_SA(0, 1), cA + hstep, voffA);
        if (wr == 1) PG8_BAR;
        PG8_WAIT_V(4); PG8_BAR;
        PG8_STAGE(PG8_SB(1, 0), cB + kstep, voffB); PG8_STAGE(PG8_SA(1, 0), cA + kstep, voffA); PG8_STAGE(PG8_SB(1, 1), cB + hstep + kstep, voffB);
        PG8_WAIT_V(6); PG8_BAR;
    }
    for (;;) {
        const bool has_next = S.next(ui + 1, nxt);
        const char* nA = has_next ? (const char*)(nxt.sel ? g.A2 : g.A) + (size_t)nxt.pm * tstep + (size_t)nxt.k0 * 2 : cA; const char* nB = has_next ? (const char*)(nxt.sel ? g.Bt2 : g.Bt) + (size_t)nxt.pn * tstep + (size_t)nxt.k0 * 2 : cB;
        const int nt = cur.nt;
        float pre[16];
        if constexpr (Epi::HAS_MID) { if (cur.mode == 1) E.pre(pre, cur, wr, fr); }
        for (int t = 0; t < nt; t += 2) {
            const bool last = (t == nt - 2);
            const char* a1 = cA + (size_t)(t + 1) * kstep;
            const char* a2 = last ? nA : cA + (size_t)(t + 2) * kstep; const char* b2 = last ? nB : cB + (size_t)(t + 2) * kstep;
            const char* a3 = a2 + kstep; const char* b3 = b2 + kstep;
            if (last && has_next) S.a_ready(nxt);
            if constexpr (SP2) {
            PG8_LDB(B0, 0, 0); PG8_LDB(B1, 0, 1); PG8_SCHED; PG8_LDA(At, 0, 0); PG8_STAGE(PG8_SA(1, 1), a1 + hstep, voffA);
            PG8_WAIT_V(8); PG8_WAIT_L(0); PG8_BAR; PG8_MMA(0, 0, At, B0); PG8_MMA(0, 1, At, B1); PG8_BAR; PG8_SCHED;
            PG8_LDA(At, 0, 1); PG8_STAGE(PG8_SB(0, 0), b2, voffB); PG8_STAGE(PG8_SB(0, 1), b2 + hstep, voffB); PG8_STAGE(PG8_SA(0, 0), a2, voffA);
            PG8_WAIT_V(8); PG8_WAIT_L(0); PG8_BAR; PG8_MMA(1, 0, At, B0); PG8_MMA(1, 1, At, B1); PG8_BAR; PG8_SCHED;
            PG8_LDB(B0, 1, 0); PG8_LDB(B1, 1, 1); PG8_SCHED; PG8_LDA(At, 1, 0); PG8_STAGE(PG8_SA(0, 1), a2 + hstep, voffA);
            PG8_WAIT_V(8); PG8_WAIT_L(0); PG8_BAR; PG8_MMA(0, 0, At, B0); PG8_MMA(0, 1, At, B1); PG8_BAR; PG8_SCHED;
            PG8_LDA(At, 1, 1); PG8_STAGE(PG8_SB(1, 0), b3, voffB); PG8_STAGE(PG8_SB(1, 1), b3 + hstep, voffB); PG8_STAGE(PG8_SA(1, 0), a3, voffA);
            PG8_WAIT_V(8); PG8_WAIT_L(0); PG8_BAR; PG8_MMA(1, 0, At, B0); PG8_MMA(1, 1, At, B1); PG8_BAR; PG8_SCHED;
            } else {
            PG8_LDB(B0, 0, 0); PG8_SCHED; PG8_LDA(At, 0, 0); PG8_STAGE(PG8_SA(1, 1), a1 + hstep, voffA);
            PG8_WAIT_L(8); PG8_BAR; PG8_WAIT_L(0); PG8_MMA(0, 0, At, B0); PG8_BAR; PG8_SCHED;
            PG8_LDB(B1, 0, 1); PG8_STAGE(PG8_SB(0, 0), b2, voffB);
            PG8_BAR; PG8_WAIT_L(0); PG8_MMA(0, 1, At, B1); PG8_BAR;
            PG8_LDA(At, 0, 1); PG8_STAGE(PG8_SA(0, 0), a2, voffA);
            PG8_BAR; PG8_WAIT_L(0); PG8_MMA(1, 0, At, B0); PG8_BAR; PG8_SCHED;
            PG8_STAGE(PG8_SB(0, 1), b2 + hstep, voffB);
            PG8_WAIT_V(6); PG8_BAR; PG8_MMA(1, 1, At, B1); PG8_BAR;
            PG8_LDB(B0, 1, 0); PG8_SCHED; PG8_LDA(At, 1, 0); PG8_STAGE(PG8_SA(0, 1), a2 + hstep, voffA);
            PG8_WAIT_L(8); PG8_BAR; PG8_WAIT_L(0); PG8_MMA(0, 0, At, B0); PG8_BAR; PG8_SCHED;
            PG8_LDB(B1, 1, 1); PG8_STAGE(PG8_SB(1, 0), b3, voffB);
            PG8_BAR; PG8_WAIT_L(0); PG8_MMA(0, 1, At, B1); PG8_BAR;
            PG8_LDA(At, 1, 1); PG8_STAGE(PG8_SA(1, 0), a3, voffA);
            PG8_BAR; PG8_WAIT_L(0); PG8_MMA(1, 0, At, B0); PG8_BAR; PG8_SCHED;
            PG8_STAGE(PG8_SB(1, 1), b3 + hstep, voffB);
            PG8_WAIT_V(6); PG8_BAR; PG8_MMA(1, 1, At, B1); PG8_BAR;
            }
        }
        if constexpr (ALIGN_EPI) { if (wr == 0) PG8_BAR; }
        bool keep = false;
        if constexpr (Epi::HAS_MID) { if (cur.mode == 1) { E.mid(acc, cur, pre, wr, wc, fr, fq); keep = true; } }
        if constexpr (!Epi::AFTER_DRAIN) { if (!keep) { E(acc, cur, wr, wc, fr, fq); S.done(cur); } }
        if (!has_next) break;
        if (!keep) {
#pragma unroll
        for (int a = 0; a < 2; ++a)
#pragma unroll
            for (int b = 0; b < 2; ++b)
#pragma unroll
                for (int m = 0; m < 4; ++m)
#pragma unroll
                    for (int n = 0; n < 2; ++n) acc[a][b][m][n] = (f32x4){0.f, 0.f, 0.f, 0.f};
        }
        cur = nxt; cA = nA; cB = nB; ++ui;
        if constexpr (ALIGN_EPI) { if (wr == 1) PG8_BAR; }
    }
    PG8_WAIT_V(0);
    if constexpr (!ALIGN_EPI) { if (wr == 0) PG8_BAR; }
    PG8_BAR;
    if constexpr (Epi::AFTER_DRAIN) { E.fused(acc, cur, wr, wc, fr, fq, lds, wid, lane); S.done(cur); }
#undef PG8_SA
#undef PG8_SB
#undef PG8_STAGE
#undef PG8_LDA
#undef PG8_LDB
#undef PG8_MMA
#undef PG8_WAIT_V
#undef PG8_WAIT_L
#undef PG8_BAR
#undef PG8_SCHED
}
}

#define GAS __attribute__((address_space(1)))
#define LAS __attribute__((address_space(3)))
typedef unsigned short bf16;
typedef unsigned v4u __attribute__((ext_vector_type(4)));
typedef unsigned v2u __attribute__((ext_vector_type(2)));
typedef float f32x4 __attribute__((ext_vector_type(4)));
typedef short bf16x8 __attribute__((ext_vector_type(8)));

constexpr int NWAVES = 8;
constexpr int DM = 2048;
constexpr int NPR = 8192, NSM = 512, MT = NPR + NSM;
constexpr int SEQ = 2048, PB = 4, SB = 128, SL = 4, PAST = 16384;
constexpr int INNER = 4096, CONVD = 6144, NH = 64, NG = 8, NST = 128;
constexpr int RH = 8, RDK = 256, RDV = 512;
constexpr int IN_DIM = 26688, LDP = 26880, NTILE_IN = LDP / 256, DT_TILE = 104;
constexpr int C_Z = 0, C_XBC = 4096, C_Q = 10240, C_K = 12288, C_V = 14336, C_G = 18432, C_GATE = 22528, C_DT = 26624;
constexpr float EPS = 1e-6f;
constexpr int NCT_P = LDP / 128, NCT_X = CONVD / 128; static_assert(NCT_P == pg8::PROJ_NCT, "PROJ tiles");

constexpr size_t MiB = 1u << 20;
constexpr size_t WS_CTL = 0, CTL_ZERO_BYTES = 1 * MiB;
constexpr size_t WS_WTIN = 1 * MiB;
constexpr size_t WS_WTPS = 106 * MiB;
constexpr size_t WS_WTPR = 122 * MiB;
constexpr size_t WS_WTO  = 138 * MiB;
constexpr size_t WS_HN   = 146 * MiB;
constexpr size_t WS_PROJ = 180 * MiB;
constexpr size_t WS_DT   = 627 * MiB;
constexpr size_t WS_DTV  = 630 * MiB;
constexpr size_t WS_LA   = 633 * MiB;
constexpr size_t WS_XBCA = 636 * MiB;
constexpr size_t WS_YS   = 738 * MiB;
constexpr size_t WS_YR   = 806 * MiB;
constexpr size_t WS_MG   = 874 * MiB;
constexpr size_t WS_OF   = 908 * MiB;
constexpr size_t WS_SPS  = 976 * MiB;
constexpr size_t WS_SPR  = 1040 * MiB;
constexpr size_t WS_ACS  = 1168 * MiB;
constexpr size_t WS_MFS  = 1171 * MiB;
constexpr size_t WS_OFS  = 1235 * MiB;
constexpr size_t WS_COS  = 1267 * MiB, WS_SIN = 1269 * MiB;
constexpr size_t WS_RSTD = 1271 * MiB;
constexpr size_t WS_END  = 1272 * MiB;
static_assert(WS_YS + (size_t)MT * INNER * 2 <= WS_YR && WS_YR + (size_t)MT * INNER * 2 <= WS_MG && WS_MG + (size_t)MT * DM * 2 <= WS_OF && WS_OF + (size_t)MT * DM * 4 <= WS_SPS, "ws map");
static_assert(WS_SPS + (size_t)PB * 16 * 64 * 64 * 128 * 2 <= WS_SPR && WS_SPR + (size_t)PB * 16 * 64 * 64 * 256 * 2 <= WS_ACS && WS_ACS + (size_t)NPR * NH * 4 <= WS_MFS, "ws map");
static_assert(WS_MFS + (size_t)16 * NSM * DM * 4 <= WS_OFS && WS_OFS + (size_t)8 * NSM * DM * 4 <= WS_COS && WS_COS + 2052 * 128 * 4 <= WS_SIN && WS_SIN + 2052 * 128 * 4 <= WS_RSTD && WS_RSTD + (size_t)MT * 16 * 4 <= WS_END, "ws map");
static_assert(WS_WTIN + (size_t)LDP * DM * 2 <= WS_WTPS && WS_PROJ + (size_t)MT * LDP * 2 <= WS_DT && WS_XBCA + (size_t)MT * CONVD * 2 <= WS_YS, "ws map");
constexpr int CW_TMO = 0, CW_BAR = 4096;

constexpr size_t O_YP = 0, O_YS = 16777216, O_CONVP = O_YS + 1048576, O_SSMP = O_CONVP + 73728, O_RETP = O_SSMP + 2097152,
                 O_CONVS = O_RETP + 4194304, O_SSMS = O_CONVS + 2359296, O_RETS = O_SSMS + 67108864, O_END = O_RETS + 134217728;

constexpr int RING_OFF = 0, RING_BYTES = 131072, LDSCTL_OFF = 147456, MISC_OFF = LDSCTL_OFF + 320, LDS_BYTES = 163840;

#define LDS_WAIT() asm volatile("s_waitcnt lgkmcnt(0)" ::: "memory")
#define VM_WAIT() asm volatile("s_waitcnt vmcnt(0)" ::: "memory")
__device__ __forceinline__ unsigned f2bf(float f) { unsigned u = __builtin_bit_cast(unsigned, f); return (u + 0x7fffu + ((u >> 16) & 1u)) >> 16; }
typedef __bf16 hwbf2 __attribute__((ext_vector_type(2)));
typedef float hwf2 __attribute__((ext_vector_type(2)));
__device__ __forceinline__ unsigned pk2(float lo, float hi) { const hwf2 v = {lo, hi}; return __builtin_bit_cast(unsigned, __builtin_convertvector(v, hwbf2)); }
__device__ __forceinline__ size_t toff(int row, int col, int nct) { return ((size_t)(row >> 7) * nct + (col >> 7)) * 16384 + (size_t)(row & 127) * 128 + (col & 127); }
__device__ __forceinline__ float bflo(unsigned w) { return __uint_as_float(w << 16); }
__device__ __forceinline__ float bfhi(unsigned w) { return __uint_as_float(w & 0xffff0000u); }
__device__ __forceinline__ float bf2f(bf16 b) { return __uint_as_float(((unsigned)b) << 16); }
__device__ __forceinline__ float sigm(float x) { return __builtin_amdgcn_rcpf(1.0f + __expf(-x)); }
__device__ __forceinline__ float siluf(float x) { return x * __builtin_amdgcn_rcpf(1.0f + __expf(-x)); }
__device__ __forceinline__ float wave_sum(float v) {
#pragma unroll
    for (int o = 1; o < 64; o <<= 1) v += __shfl_xor(v, o);
    return v;
}
#define XB_TMO      128
#define XB_XCNT(j)  (256  + 64 * (j))
#define XB_XSUB(j)  (1280 + 64 * (j))
#define XB_XGEN(j)  (2304 + 64 * (j))
#define XB_TOP      3328
#define XB_TOPGEN   3392
#define XCD_BAR_WORDS 3456
#define XB_SPIN_CAP (1u << 18)

__device__ __forceinline__ unsigned xb_ld(unsigned* p)              { return __hip_atomic_load(p, __ATOMIC_RELAXED, __HIP_MEMORY_SCOPE_AGENT); }
__device__ __forceinline__ unsigned xb_add(unsigned* p, unsigned v) { return __hip_atomic_fetch_add(p, v, __ATOMIC_RELAXED, __HIP_MEMORY_SCOPE_AGENT); }
__device__ __forceinline__ unsigned xb_xcc_id() { return (unsigned)__builtin_amdgcn_s_getreg((3 << 11) | 20) & 0xFu; }
#define XB_SPIN(cond, bar) do { unsigned _sp = 0; while (cond) { __builtin_amdgcn_s_sleep(1); \
    if ((++_sp & 255u) == 0u) { if (xb_ld(&(bar)[XB_TMO])) break; if (_sp > XB_SPIN_CAP) { atomicAdd(&(bar)[XB_TMO], 1u); break; } } } } while (0)

struct XcdBarrier {
    unsigned* bar; unsigned x;
    volatile LAS unsigned* st;
};

__device__ __forceinline__ XcdBarrier xcd_barrier_post(unsigned* bar, volatile LAS unsigned* st) {
    XcdBarrier b; b.bar = bar; b.x = xb_xcc_id(); b.st = st;
    if (threadIdx.x == 0) (void)xb_add(&bar[XB_XCNT(b.x)], 1u);
    return b;
}
__device__ __forceinline__ void xcd_barrier_complete(unsigned* bar, unsigned x, unsigned& nloc, unsigned& nx) {
    const unsigned G = gridDim.x * gridDim.y * gridDim.z;
    unsigned sum, cnt, mine, sp = 0u;
    for (;;) {
        sum = 0u; cnt = 0u; mine = 0u;
#pragma unroll
        for (unsigned j = 0; j < 16; ++j) { const unsigned c = xb_ld(&bar[XB_XCNT(j)]); sum += c; cnt += (c > 0u) ? 1u : 0u; mine = (j == x) ? c : mine; }
        if (sum == G) break;
        __builtin_amdgcn_s_sleep(1);
        if ((++sp & 255u) == 0u) { if (xb_ld(&bar[XB_TMO])) break; if (sp > XB_SPIN_CAP) { atomicAdd(&bar[XB_TMO], 1u); break; } }
    }
    nloc = mine > 0u ? mine : 1u; nx = cnt > 0u ? cnt : 1u;
}

__device__ __forceinline__ void xcd_barrier(const XcdBarrier& b) {
    asm volatile("s_waitcnt vmcnt(0)" ::: "memory");
    __syncthreads();
    if (threadIdx.x == 0) {
        unsigned* bar = b.bar;
        __builtin_amdgcn_s_waitcnt(0);
        unsigned nloc = b.st[0], nx = b.st[1];
        if (nloc == 0u) { xcd_barrier_complete(bar, b.x, nloc, nx); b.st[0] = nloc; b.st[1] = nx; }
        const unsigned old = xb_add(&bar[XB_XSUB(b.x)], 1u);
        const unsigned gen = old / nloc;
        if (old + 1u == (gen + 1u) * nloc) {
            __builtin_amdgcn_fence(__ATOMIC_RELEASE, "agent");
            asm volatile("s_waitcnt vmcnt(0)" ::: "memory");
            const unsigned og = xb_add(&bar[XB_TOP], 1u);
            const unsigned tg = og / nx;
            if (og + 1u == (tg + 1u) * nx) xb_add(&bar[XB_TOPGEN], 1u);
            else XB_SPIN(xb_ld(&bar[XB_TOPGEN]) == tg, bar);
            __builtin_amdgcn_fence(__ATOMIC_ACQUIRE, "agent");
            xb_add(&bar[XB_XGEN(b.x)], 1u);
            asm volatile("s_waitcnt vmcnt(0)" ::: "memory");
        } else {
            XB_SPIN(xb_ld(&bar[XB_XGEN(b.x)]) == gen, bar);
            __builtin_amdgcn_fence(__ATOMIC_ACQUIRE, "agent");
            asm volatile("s_waitcnt vmcnt(0)" ::: "memory");
        }
    }
    __syncthreads();
}

struct Args { const float* in[17]; float* out; unsigned char* ws; int ph_lo, ph_hi; };
enum { I_XP = 0, I_XS, I_CCONV, I_SSSM, I_SRET, I_WPRE, I_WIN, I_CONVW, I_CONVB, I_DTB, I_ALOG, I_DSKIP, I_SNW, I_WPS, I_WPR, I_WOUT, I_WPOST };

__device__ __forceinline__ void p0_transpose_item(const float* W, int K, int N, bf16* WT, int k0, int n0, int dst_row0, LAS float* scr, int lane) {
    float tv[64];
#pragma unroll
    for (int i = 0; i < 64; ++i) tv[i] = W[(size_t)(k0 + i) * N + n0 + lane];
#pragma unroll
    for (int i = 0; i < 64; ++i) scr[i * 65 + lane] = tv[i];
    LDS_WAIT(); asm volatile("" ::: "memory");
    const int c = lane & 7;
#pragma unroll
    for (int j = 0; j < 8; ++j) { const int n = (lane >> 3) + 8 * j; const LAS float* s = scr + (8 * c) * 65 + n;
        v4u o; o.x = pk2(s[0 * 65], s[1 * 65]); o.y = pk2(s[2 * 65], s[3 * 65]); o.z = pk2(s[4 * 65], s[5 * 65]); o.w = pk2(s[6 * 65], s[7 * 65]);
        *(GAS v4u*)(WT + (size_t)(dst_row0 + n) * K + k0 + 8 * c) = o; }
    LDS_WAIT(); asm volatile("" ::: "memory");
}
__device__ __forceinline__ const float* x_row(const Args& a, int m) { return m < NPR ? a.in[I_XP] + (size_t)m * DM : a.in[I_XS] + (size_t)(m - NPR) * DM; }

__device__ __forceinline__ void p0_prologue(const Args& a, LAS unsigned char* lds, int wave, int lane) {
    LAS float* scr = (LAS float*)(lds + RING_OFF + wave * 16896);
    const int gw = blockIdx.x * NWAVES + wave, NGW = gridDim.x * NWAVES;
    bf16* WTIN = (bf16*)(a.ws + WS_WTIN); bf16* WTPS = (bf16*)(a.ws + WS_WTPS); bf16* WTPR = (bf16*)(a.ws + WS_WTPR); bf16* WTO = (bf16*)(a.ws + WS_WTO);
    constexpr int NB_IN = IN_DIM / 64;
    constexpr int I_IN = (DM / 64) * NB_IN, I_PS = (INNER / 64) * (DM / 64), I_PR = I_PS, I_O = (DM / 64) * (DM / 64);
    constexpr int NITEMS = I_IN + I_PS + I_PR + I_O;
    for (int it = gw; it < NITEMS; it += NGW) {
        int r = it;
        if (r < I_IN) { const int kb = r / NB_IN, nb = r % NB_IN, n0 = 64 * nb; const int d0 = n0 < 10240 ? n0 : (n0 < 10304 ? n0 + 16384 : n0 - 64);
            p0_transpose_item(a.in[I_WIN], DM, IN_DIM, WTIN, 64 * kb, n0, d0, scr, lane); continue; }
        r -= I_IN;
        if (r < I_PS) { const int kb = r / (DM / 64), nb = r % (DM / 64); p0_transpose_item(a.in[I_WPS], INNER, DM, WTPS, 64 * kb, 64 * nb, 64 * nb, scr, lane); continue; }
        r -= I_PS;
        if (r < I_PR) { const int kb = r / (DM / 64), nb = r % (DM / 64); p0_transpose_item(a.in[I_WPR], INNER, DM, WTPR, 64 * kb, 64 * nb, 64 * nb, scr, lane); continue; }
        r -= I_PR;
        { const int kb = r / (DM / 64), nb = r % (DM / 64); p0_transpose_item(a.in[I_WOUT], DM, DM, WTO, 64 * kb, 64 * nb, 64 * nb, scr, lane); }
    }
    { GAS v4u* z = (GAS v4u*)(WTIN + (size_t)IN_DIM * DM); const int nz = (LDP - IN_DIM) * DM / 8;
      for (int i = blockIdx.x * 512 + threadIdx.x; i < nz; i += gridDim.x * 512) z[i] = (v4u){0u, 0u, 0u, 0u}; }
    { float* COS = (float*)(a.ws + WS_COS); float* SIN = (float*)(a.ws + WS_SIN);
      for (int i = blockIdx.x * 512 + threadIdx.x; i < 2052 * 128; i += gridDim.x * 512) { const int pi = i >> 7, f = i & 127, pos = pi < 2048 ? pi : PAST + (pi - 2048);
          const double inv = exp2(-(double)f * (13.287712379549449 / 128.0)), ang = (double)pos * inv; COS[i] = (float)cos(ang); SIN[i] = (float)sin(ang); } }
    bf16* HN = (bf16*)(a.ws + WS_HN);
    const GAS f32x4* wp = (const GAS f32x4*)a.in[I_WPRE] + lane;
    for (int m = gw; m < MT; m += NGW) {
        const GAS f32x4* xr = (const GAS f32x4*)x_row(a, m) + lane;
        f32x4 v[8]; float s = 0.f;
#pragma unroll
        for (int j = 0; j < 8; ++j) { v[j] = xr[64 * j]; s += (v[j].x * v[j].x + v[j].y * v[j].y) + (v[j].z * v[j].z + v[j].w * v[j].w); }
        const float rstd = 1.0f / sqrtf(wave_sum(s) * (1.0f / DM) + EPS);
        GAS v2u* o8 = (GAS v2u*)(HN + (size_t)m * DM) + lane;
#pragma unroll
        for (int j = 0; j < 8; ++j) { const f32x4 w = wp[64 * j]; v2u o; o.x = pk2(v[j].x * rstd * w.x, v[j].y * rstd * w.y); o.y = pk2(v[j].z * rstd * w.z, v[j].w * rstd * w.w); o8[64 * j] = o; }
    }
}

__device__ __forceinline__ void p2_prep(const Args& a, LAS unsigned char* lds) {
    const bf16* PROJ = (const bf16*)(a.ws + WS_PROJ); bf16* PROJW = (bf16*)(a.ws + WS_PROJ);
    bf16* XBCA = (bf16*)(a.ws + WS_XBCA);
    const size_t gt = (size_t)blockIdx.x * 512 + threadIdx.x, NT = (size_t)gridDim.x * 512;
    const float* cw = a.in[I_CONVW]; const float* cb = a.in[I_CONVB]; const float* cache = a.in[I_CCONV];
    for (size_t it = gt; it < (size_t)(MT / 32) * (CONVD / 8); it += NT) {
        const int cg = (int)(it % (CONVD / 8)), seg = (int)(it / (CONVD / 8)), j0 = cg * 8, m0 = seg * 32;
        float w[4][8], bs[8], x0[8], x1[8], x2[8];
#pragma unroll
        for (int e = 0; e < 8; ++e) { bs[e] = cb[j0 + e];
#pragma unroll
            for (int tap = 0; tap < 4; ++tap) w[tap][e] = cw[tap * CONVD + j0 + e]; }
#define UNPK8(dst, v) do { dst[0] = bflo(v.x); dst[1] = bfhi(v.x); dst[2] = bflo(v.y); dst[3] = bfhi(v.y); dst[4] = bflo(v.z); dst[5] = bfhi(v.z); dst[6] = bflo(v.w); dst[7] = bfhi(v.w); } while (0)
        if (m0 < NPR && (m0 % SEQ) != 0) { const v4u v0 = *(const v4u*)(PROJ + toff(m0 - 3, C_XBC + j0, NCT_P)), v1 = *(const v4u*)(PROJ + toff(m0 - 2, C_XBC + j0, NCT_P)), v2 = *(const v4u*)(PROJ + toff(m0 - 1, C_XBC + j0, NCT_P));
            UNPK8(x0, v0); UNPK8(x1, v1); UNPK8(x2, v2); }
        else {
#pragma unroll
            for (int e = 0; e < 8; ++e) { x0[e] = 0.f; x1[e] = 0.f; x2[e] = 0.f; } }
#pragma unroll 1
        for (int r0 = 0; r0 < 32; r0 += 8) { v4u vv[8];
#pragma unroll
          for (int q = 0; q < 8; ++q) vv[q] = *(const v4u*)(PROJ + toff(m0 + r0 + q, C_XBC + j0, NCT_P));
#pragma unroll
          for (int q = 0; q < 8; ++q) { const int m = m0 + r0 + q;
            if (m >= NPR && ((m - NPR) % SL) == 0) { const float* cp = cache + (size_t)((m - NPR) / SL) * 3 * CONVD + j0;
#pragma unroll
                for (int e = 0; e < 8; ++e) { x0[e] = cp[e]; x1[e] = cp[CONVD + e]; x2[e] = cp[2 * CONVD + e]; } }
            const v4u v = vv[q]; float x3[8]; UNPK8(x3, v);
            float o[8];
#pragma unroll
            for (int e = 0; e < 8; ++e) { o[e] = siluf(bs[e] + w[0][e] * x0[e] + w[1][e] * x1[e] + w[2][e] * x2[e] + w[3][e] * x3[e]); x0[e] = x1[e]; x1[e] = x2[e]; x2[e] = x3[e]; }
            v4u ov; ov.x = pk2(o[0], o[1]); ov.y = pk2(o[2], o[3]); ov.z = pk2(o[4], o[5]); ov.w = pk2(o[6], o[7]);
            *(v4u*)(XBCA + toff(m, j0, NCT_X)) = ov; } }
#undef UNPK8
    }
    for (size_t i = gt; i < (size_t)(PB + SB) * 3 * CONVD; i += NT) {
        const int j = (int)(i % CONVD), bi = (int)(i / CONVD), ii = bi % 3, b = bi / 3;
        if (b < PB) a.out[O_CONVP + ((size_t)b * 3 + ii) * CONVD + j] = bf2f(PROJ[toff(b * SEQ + SEQ - 3 + ii, C_XBC + j, NCT_P)]);
        else { const int bs = b - PB; a.out[O_CONVS + ((size_t)bs * 3 + ii) * CONVD + j] = bf2f(PROJ[toff(NPR + bs * SL + 1 + ii, C_XBC + j, NCT_P)]); }
    }
    { const float* DT = (const float*)(a.ws + WS_DT); float* DTV = (float*)(a.ws + WS_DTV); float* LA = (float*)(a.ws + WS_LA);
      for (size_t i = gt; i < (size_t)MT * NH; i += NT) { const int h = (int)(i & 63); const float x = DT[i] + a.in[I_DTB][h];
          const float sp = x > 20.f ? x : log1pf(expf(x)); DTV[i] = sp; LA[i] = -sp * expf(a.in[I_ALOG][h]); }
      float* ACS = (float*)(a.ws + WS_ACS); const int lane = threadIdx.x & 63, wv = threadIdx.x >> 6;
      const float bias = a.in[I_DTB][lane], an = -expf(a.in[I_ALOG][lane]);
      LAS float* WT = (LAS float*)(lds + 8192);
      for (int ck = blockIdx.x; ck < NPR / 128; ck += gridDim.x) { float cs[16]; float acc = 0.f;
#pragma unroll
          for (int e = 0; e < 16; ++e) cs[e] = DT[(size_t)(ck * 128 + wv * 16 + e) * NH + lane] + bias;
#pragma unroll
          for (int e = 0; e < 16; ++e) { const float sp = cs[e] > 20.f ? cs[e] : log1pf(expf(cs[e])); acc += sp * an; cs[e] = acc; }
          __syncthreads(); WT[wv * 64 + lane] = acc; __syncthreads();
          float off = 0.f;
#pragma unroll
          for (int w2 = 0; w2 < 8; ++w2) off += (w2 < wv) ? WT[w2 * 64 + lane] : 0.f;
#pragma unroll
          for (int e = 0; e < 16; ++e) ACS[(size_t)(ck * 128 + wv * 16 + e) * NH + lane] = off + cs[e]; } }
}

__device__ __forceinline__ void p8_final(const Args& a, int wave, int lane) {
    const float* OF = (const float*)(a.ws + WS_OF);
    const int gw = blockIdx.x * NWAVES + wave, NGW = gridDim.x * NWAVES;
    const GAS f32x4* wp = (const GAS f32x4*)a.in[I_WPOST] + lane;
    for (int m = gw; m < MT; m += NGW) {
        const GAS f32x4* orow = (const GAS f32x4*)(OF + (size_t)m * DM) + lane; const GAS f32x4* xr = (const GAS f32x4*)x_row(a, m) + lane;
        f32x4 v[8]; float s = 0.f;
#pragma unroll
        for (int j = 0; j < 8; ++j) {
            if (m < NPR) v[j] = orow[64 * j];
            else { const GAS f32x4* ps = (const GAS f32x4*)((const float*)(a.ws + WS_OFS) + (size_t)(m - NPR) * DM) + lane + 64 * j; v[j] = ps[0];
#pragma unroll
                for (int ks = 1; ks < 8; ++ks) v[j] += ps[(size_t)ks * (NSM * DM / 4)]; }
            s += (v[j].x * v[j].x + v[j].y * v[j].y) + (v[j].z * v[j].z + v[j].w * v[j].w); }
        const float rstd = 1.0f / sqrtf(wave_sum(s) * (1.0f / DM) + EPS);
        GAS f32x4* yo = (GAS f32x4*)(a.out + (size_t)m * DM) + lane;
#pragma unroll
        for (int j = 0; j < 8; ++j) { const f32x4 w = wp[64 * j], x = xr[64 * j]; yo[64 * j] = x + v[j] * rstd * w; }
    }
}

__device__ __forceinline__ void p7_merge_sample(const Args& a) {
    const f32x4* src = (const f32x4*)(a.ws + WS_MFS); v4u* dst = (v4u*)((bf16*)(a.ws + WS_MG) + (size_t)NPR * DM);
    for (size_t i = (size_t)blockIdx.x * 512 + threadIdx.x; i < (size_t)NSM * DM / 8; i += (size_t)gridDim.x * 512) { f32x4 x0 = src[2 * i], x1 = src[2 * i + 1];
#pragma unroll
        for (int ks = 1; ks < 16; ++ks) { x0 += src[(size_t)ks * (NSM * DM / 4) + 2 * i]; x1 += src[(size_t)ks * (NSM * DM / 4) + 2 * i + 1]; }
        v4u o; o.x = pk2(x0.x, x0.y); o.y = pk2(x0.z, x0.w); o.z = pk2(x1.x, x1.y); o.w = pk2(x1.z, x1.w); dst[i] = o; }
}

typedef short s4v __attribute__((ext_vector_type(4)));
constexpr int TAB0 = LDSCTL_OFF + 1024, TAB1 = TAB0 + 4096;
static_assert(TAB1 + 4096 <= LDS_BYTES, "LDS tables");
__device__ __forceinline__ unsigned img_off(unsigned row, unsigned ch) { return 256u * row + 16u * (ch ^ (((row & 3u) << 2) | ((row >> 2) & 3u))); }
__device__ __forceinline__ s4v tr_rd(LAS unsigned char* p) { return __builtin_amdgcn_ds_read_tr16_b64_v4i16((LAS s4v*)p); }
__device__ __forceinline__ bf16x8 mk8(s4v a, s4v b) { return (bf16x8){a[0], a[1], a[2], a[3], b[0], b[1], b[2], b[3]}; }
__device__ __forceinline__ float ret_lg2(int hh) { return log2f(1.0f - exp2f(-5.0f - (float)hh)); }
#define MFMA16(a, b, c) __builtin_amdgcn_mfma_f32_16x16x32_bf16((a), (b), (c), 0, 0, 0)

__device__ __forceinline__ unsigned img64_off(unsigned row, unsigned ch) { return 128u * row + 16u * (ch ^ (((row >> 1) & 3u) << 1)); }
__device__ __forceinline__ void dma16(const void* g, LAS unsigned char* l) {
    const unsigned lds_dst = __builtin_amdgcn_readfirstlane((unsigned)(size_t)l); unsigned keep;
    asm volatile("s_mov_b32 %0, m0\n\ts_mov_b32 m0, %2\n\ts_nop 0\n\tglobal_load_lds_dwordx4 %1, off\n\ts_mov_b32 m0, %0" : "=&s"(keep) : "v"(g), "s"(lds_dst) : "memory");
}
template <int NROWS> __device__ __forceinline__ void stage256(const bf16* src, size_t ld, LAS unsigned char* dst, int wave, int lane) {
#pragma unroll
    for (int i0 = 0; i0 < NROWS / 4; i0 += 8) { const int i = i0 + wave, row = 4 * i + (lane >> 4), cs = lane & 15, ch = cs ^ (((row & 3) << 2) | ((row >> 2) & 3));
        dma16(src + (size_t)row * ld + ch * 8, dst + i * 1024); }
}
template <int NROWS> __device__ __forceinline__ void stage128(const bf16* src, size_t ld, LAS unsigned char* dst, int wave, int lane) {
#pragma unroll
    for (int i0 = 0; i0 < NROWS / 8; i0 += 8) { const int i = i0 + wave, row = 8 * i + (lane >> 3), cs = lane & 7, ch = cs ^ (((row >> 1) & 3) << 1);
        dma16(src + (size_t)row * ld + ch * 8, dst + i * 1024); }
}
struct PCtx { unsigned char* ws; const float* dskip; const float* snw; };
template <bool RET> __device__ __forceinline__ void passC_unit(const PCtx a, LAS unsigned char* lds, int b, int c, int gi, int tid, int wave, int lane) {
    constexpr int N = RET ? 256 : 128, NKI = N / 128, NKS = N / 32;
    constexpr int NB = RET ? 2 : 3, BUFSZ = RET ? 65536 : 49152, K_OFF = RET ? 65536 : 114688, S_OFF = 32768, Z_OFF = 16384, TNW_OFF = LDSCTL_OFF + 9216;
    const size_t R0 = (size_t)b * SEQ + (size_t)c * 128;
    const bf16* PROJ = (const bf16*)(a.ws + WS_PROJ); const bf16* XBCA = (const bf16*)(a.ws + WS_XBCA);
    const float* DTV = (const float*)(a.ws + WS_DTV); const float* ACS = (const float*)(a.ws + WS_ACS);
    constexpr size_t ld = 128;
    const bf16* Ksrc = RET ? PROJ + toff((int)R0, C_K + gi * 256, NCT_P) : XBCA + toff((int)R0, INNER + gi * 128, NCT_X);
    const bf16* Qsrc = RET ? PROJ + toff((int)R0, C_Q + gi * 256, NCT_P) : XBCA + toff((int)R0, INNER + NG * NST + gi * 128, NCT_X);
    const bf16* Xsrc = RET ? PROJ + toff((int)R0, C_V + gi * 512, NCT_P) : XBCA + toff((int)R0, gi * 512, NCT_X);
    const bf16* Zsrc = PROJ + toff((int)R0, (RET ? C_G : C_Z) + gi * 512, NCT_P);
    LAS float* TNW = (LAS float*)(lds + TNW_OFF);
    const bf16* SP = (const bf16*)(a.ws + (RET ? WS_SPR : WS_SPS)) + (size_t)((b * 16 + c) * 8 + gi) * 8 * 64 * N;
    bf16* Yout = (bf16*)(a.ws + (RET ? WS_YR : WS_YS)) + R0 * INNER + gi * 512;
    LAS float* TA = (LAS float*)(lds + TAB0); LAS float* TD = (LAS float*)(lds + TAB1);
    const int g4 = lane >> 4, l15 = lane & 15, q4 = l15 >> 2, p4 = lane & 3, L0 = 16 * wave, lrow = L0 + l15;
    const int ps = (p4 == 1) ? 2 : (p4 == 2 ? 1 : p4), gs = (g4 == 1) ? 2 : (g4 == 2 ? 1 : g4), l15s = 4 * ((q4 == 1) ? 2 : (q4 == 2 ? 1 : q4)) + (l15 & 3);
    const bool up = lane >= 32; const int nst = up ? ((g4 == 3) ? 8 : 0) : 4 * gs;
    const float lg2 = RET ? ret_lg2(gi) : 0.f;
#define STAGE_R(r_) do { LAS unsigned char* bb_ = lds + ((r_) % NB) * BUFSZ; \
        stage128<128>(Xsrc + ((r_) >> 1) * 16384 + ((r_) & 1) * 64, ld, bb_, wave, lane); \
        stage128<128>(Zsrc + ((r_) >> 1) * 16384 + ((r_) & 1) * 64, ld, bb_ + Z_OFF, wave, lane); \
        _Pragma("unroll") for (int h_ = 0; h_ < NKI; ++h_) stage256<64>(SP + (size_t)(r_) * 64 * N + h_ * 128, (size_t)N, bb_ + S_OFF + h_ * 16384, wave, lane); } while (0)
    __syncthreads();
#pragma unroll
    for (int h = 0; h < NKI; ++h) stage256<128>(Ksrc + h * 16384, ld, lds + K_OFF + h * 32768, wave, lane);
    STAGE_R(0);
    if (!RET) STAGE_R(1);
    if (!RET) { for (int i = tid; i < 1024; i += 512) { const int r = i >> 7, s = i & 127; TA[i] = ACS[(R0 + s) * NH + gi * 8 + r]; TD[i] = DTV[(R0 + s) * NH + gi * 8 + r]; }
        TNW[tid] = a.snw[gi * 512 + tid]; }
    bf16x8 qf[NKS];
#pragma unroll
    for (int ks = 0; ks < NKS; ++ks) qf[ks] = *(const bf16x8*)(Qsrc + (ks >> 2) * 16384 + (size_t)lrow * ld + 32 * (ks & 3) + 8 * g4);
    asm volatile("s_waitcnt vmcnt(0)" ::: "memory");
    __syncthreads();
    f32x4 gt[8];
#pragma unroll
    for (int si = 0; si < 8; ++si) { gt[si] = (f32x4){0.f, 0.f, 0.f, 0.f};
        if (si <= wave) {
#pragma unroll
            for (int ks = 0; ks < NKS; ++ks) { const bf16x8 ka = *(const LAS bf16x8*)(lds + K_OFF + (ks >> 2) * 32768 + img_off(16 * si + l15, 4 * (ks & 3) + g4)); gt[si] = MFMA16(ka, qf[ks], gt[si]); }
            asm volatile("" ::: "memory"); } }
    bf16x8 mt[4];
    if (RET) {
#pragma unroll
        for (int kp = 0; kp < 4; ++kp) { float v[8];
#pragma unroll
            for (int t = 0; t < 2; ++t)
#pragma unroll
                for (int i = 0; i < 4; ++i) { const int s = 32 * kp + 16 * t + 4 * g4 + i; v[4 * t + i] = (s <= lrow) ? gt[2 * kp + t][i] * exp2f(lg2 * (float)(lrow - s)) : 0.f; }
            const unsigned w0 = pk2(v[0], v[1]), w1 = pk2(v[2], v[3]), w2 = pk2(v[4], v[5]), w3 = pk2(v[6], v[7]);
            mt[kp] = __builtin_bit_cast(bf16x8, (v4u){w0, w1, w2, w3}); }
    }
    float ssq = 0.f;
    __syncthreads();
    if (RET) STAGE_R(1);
#pragma unroll 1
    for (int r = 0; r < 8; ++r) {
        if (RET) { if (r >= 1 && r < 7) STAGE_R(r + 1); }
        else if (r < 6) STAGE_R(r + 2);
        LAS unsigned char* bb = lds + (r % NB) * BUFSZ;
        float el;
        if (RET) el = exp2f(lg2 * (float)(lrow + 1));
        else { const float al = TA[r * 128 + lrow]; el = __expf(al);
#pragma unroll
            for (int kp = 0; kp < 4; ++kp) if (2 * kp <= wave) { float v[8];
#pragma unroll
                for (int t = 0; t < 2; ++t) { const int s0 = 32 * kp + 16 * t + 4 * g4; const f32x4 as = *(const LAS f32x4*)(TA + r * 128 + s0), ds = *(const LAS f32x4*)(TD + r * 128 + s0);
#pragma unroll
                    for (int i = 0; i < 4; ++i) v[4 * t + i] = (s0 + i <= lrow) ? gt[2 * kp + t][i] * __expf(al - as[i]) * ds[i] : 0.f; }
                const unsigned w0 = pk2(v[0], v[1]), w1 = pk2(v[2], v[3]), w2 = pk2(v[4], v[5]), w3 = pk2(v[6], v[7]);
                mt[kp] = __builtin_bit_cast(bf16x8, (v4u){w0, w1, w2, w3}); } }
        const float Dh = RET ? 0.f : a.dskip[gi * 8 + r];
        v2u yp[2];
#pragma unroll 1
        for (int pp2 = 0; pp2 < 2; ++pp2)
#pragma unroll
        for (int ph = 0; ph < 2; ++ph) { const int pt = 2 * pp2 + ph;
            f32x4 ai = (f32x4){0.f, 0.f, 0.f, 0.f}, ae = (f32x4){0.f, 0.f, 0.f, 0.f};
            LAS unsigned char* xb = bb + 8 * (ps & 1);
#pragma unroll
            for (int kp = 0; kp < 4; ++kp) if (2 * kp <= wave) {
                const s4v lo = tr_rd(xb + img64_off(32 * kp + 4 * g4 + q4, 2 * pt + (ps >> 1))), hi = tr_rd(xb + img64_off(32 * kp + 16 + 4 * g4 + q4, 2 * pt + (ps >> 1)));
                ai = MFMA16(mk8(lo, hi), mt[kp], ai); }
#pragma unroll
            for (int ks = 0; ks < NKS; ++ks) { const bf16x8 sa = *(const LAS bf16x8*)(bb + S_OFF + (ks >> 2) * 16384 + img_off(16 * pt + l15s, 4 * (ks & 3) + g4)); ae = MFMA16(sa, qf[ks], ae); }
            float y[4];
#pragma unroll
            for (int i = 0; i < 4; ++i) y[i] = ai[i] + el * ae[i];
            const unsigned xo = img64_off(lrow, 2 * pt + (gs >> 1)) + 8 * (gs & 1);
            const v2u zw = *(const LAS v2u*)(bb + Z_OFF + xo);
            if (!RET) {
                const v2u xw = *(const LAS v2u*)(bb + xo);
                y[0] = (y[0] + Dh * bflo(xw.x)) * siluf(bflo(zw.x)); y[1] = (y[1] + Dh * bfhi(xw.x)) * siluf(bfhi(zw.x));
                y[2] = (y[2] + Dh * bflo(xw.y)) * siluf(bflo(zw.y)); y[3] = (y[3] + Dh * bfhi(xw.y)) * siluf(bfhi(zw.y));
            }
            ssq += (y[0] * y[0] + y[1] * y[1]) + (y[2] * y[2] + y[3] * y[3]);
            if (RET) { y[0] *= siluf(bflo(zw.x)); y[1] *= siluf(bfhi(zw.x)); y[2] *= siluf(bflo(zw.y)); y[3] *= siluf(bfhi(zw.y)); }
            else { const f32x4 nw = *(const LAS f32x4*)(TNW + r * 64 + 16 * pt + 4 * gs); y[0] *= nw.x; y[1] *= nw.y; y[2] *= nw.z; y[3] *= nw.w; }
            yp[ph].x = pk2(y[0], y[1]); yp[ph].y = pk2(y[2], y[3]);
            if (ph) {
                const unsigned sx = up ? yp[0].x : yp[1].x, sy = up ? yp[0].y : yp[1].y; const unsigned rx = (unsigned)__shfl_xor((int)sx, 32), ry = (unsigned)__shfl_xor((int)sy, 32);
                const v4u w = up ? (v4u){rx, ry, yp[1].x, yp[1].y} : (v4u){yp[0].x, yp[0].y, rx, ry};
                *(v4u*)(Yout + (size_t)lrow * INNER + r * 64 + 16 * (pt - 1 + (up ? 1 : 0)) + nst) = w; }
        }
        if (RET) { if (r < 7) asm volatile("s_waitcnt vmcnt(2)" ::: "memory"); else asm volatile("s_waitcnt vmcnt(0)" ::: "memory"); }
        else { if (r < 6) asm volatile("s_waitcnt vmcnt(8)" ::: "memory"); else asm volatile("s_waitcnt vmcnt(0)" ::: "memory"); }
        __builtin_amdgcn_s_barrier();
        asm volatile("" ::: "memory");
    }
#undef STAGE_R
    ssq += __shfl_xor(ssq, 16); ssq += __shfl_xor(ssq, 32);
    if (g4 == 0) ((float*)(a.ws + WS_RSTD))[(R0 + lrow) * 16 + (RET ? 8 : 0) + gi] = 1.0f / sqrtf(ssq * (1.0f / 512.0f) + EPS);
}

__device__ __forceinline__ void passC(unsigned char* ws, const float* dskip, const float* snw, LAS unsigned char* lds) {
    const PCtx a{ws, dskip, snw}; const int tid = threadIdx.x, lane = tid & 63, wave = __builtin_amdgcn_readfirstlane(tid >> 6);
#if !defined(ONLY_SSD)
    for (int u = blockIdx.x; u < 512; u += gridDim.x) passC_unit<true>(a, lds, u >> 7, (u >> 3) & 15, u & 7, tid, wave, lane);
#endif
#if !defined(ONLY_RET)
    for (int u = blockIdx.x; u < 512; u += gridDim.x) passC_unit<false>(a, lds, u >> 7, (u >> 3) & 15, u & 7, tid, wave, lane);
#endif
}

template <bool RET> __device__ __forceinline__ void scan_unit(const Args& a, LAS unsigned char* lds, int b, int gi, int rp, int nh, int tid, int wave, int lane) {
    constexpr int N = RET ? 256 : 128;
    const bf16* PROJ = (const bf16*)(a.ws + WS_PROJ); const bf16* XBCA = (const bf16*)(a.ws + WS_XBCA);
    const float* DTV = (const float*)(a.ws + WS_DTV); const float* ACS = (const float*)(a.ws + WS_ACS);
    constexpr size_t ld = 128, CSTEP = (size_t)(RET ? NCT_P : NCT_X) * 16384;
    const size_t Rb = (size_t)b * SEQ;
    const bf16* Ksrc = RET ? PROJ + toff((int)Rb, C_K + gi * 256 + nh * 128, NCT_P) : XBCA + toff((int)Rb, INNER + gi * 128, NCT_X);
    const bf16* Xsrc = RET ? PROJ + toff((int)Rb, C_V + gi * 512 + rp * 128, NCT_P) : XBCA + toff((int)Rb, gi * 512 + rp * 128, NCT_X);
    bf16* SP = (bf16*)(a.ws + (RET ? WS_SPR : WS_SPS));
    LAS float* TBL = (LAS float*)(lds + 131072);
    const int g4 = lane >> 4, l15 = lane & 15, q4 = l15 >> 2, p4 = lane & 3;
    const int ps = (p4 == 1) ? 2 : (p4 == 2 ? 1 : p4), gs = (g4 == 1) ? 2 : (g4 == 2 ? 1 : g4);
    const bool up = lane >= 32; const int nst = up ? ((g4 == 3) ? 8 : 0) : 4 * gs;
    const float lg2 = RET ? ret_lg2(gi) : 0.f;
    float wb[4], wj[8]; const float decR = RET ? exp2f(lg2 * 128.f) : 0.f;
#pragma unroll
    for (int ks = 0; ks < 4; ++ks) wb[ks] = RET ? exp2f(lg2 * (float)(127 - (32 * ks + 8 * g4))) : 0.f;
#pragma unroll
    for (int j = 0; j < 8; ++j) wj[j] = RET ? exp2f(-lg2 * (float)j) : 0.f;
#define SC_STAGE_K(c_) stage256<128>(Ksrc + (size_t)(c_) * CSTEP, ld, lds + ((2 * (c_)) & 3) * 32768, wave, lane)
#define SC_STAGE_X(c_) stage256<128>(Xsrc + (size_t)(c_) * CSTEP, ld, lds + ((2 * (c_) + 1) & 3) * 32768, wave, lane)
#define SC_TBLVAL(c_, dst) do { if (!RET && tid < 258) { const int rr_ = tid < 256 ? (tid >> 7) : (tid - 256), s_ = tid < 256 ? (tid & 127) : 127; const int h_ = gi * 8 + 2 * rp + rr_; \
            const size_t r0_ = Rb + (size_t)(c_) * 128; const float aend_ = ACS[(r0_ + 127) * NH + h_]; \
            dst = tid < 256 ? DTV[(r0_ + s_) * NH + h_] * __expf(aend_ - ACS[(r0_ + s_) * NH + h_]) : __expf(aend_); } } while (0)
    f32x4 acc[2][4];
#pragma unroll
    for (int rr = 0; rr < 2; ++rr)
#pragma unroll
        for (int pt = 0; pt < 4; ++pt) acc[rr][pt] = (f32x4){0.f, 0.f, 0.f, 0.f};
    __syncthreads();
    SC_STAGE_K(0); SC_STAGE_X(0); SC_STAGE_K(1);
    { float tv = 0.f; SC_TBLVAL(0, tv); if (!RET && tid < 258) TBL[tid] = tv; }
    asm volatile("s_waitcnt vmcnt(0)" ::: "memory");
    __syncthreads();
#pragma unroll 1
    for (int c = 0; c < 16; ++c) {
        if (c < 15) SC_STAGE_X(c + 1);
        bf16x8 kf[4];
        { LAS unsigned char* kb = lds + ((2 * c) & 3) * 32768 + 8 * (ps & 1);
#pragma unroll
          for (int ks = 0; ks < 4; ++ks) { const s4v lo = tr_rd(kb + img_off(32 * ks + 8 * g4 + q4, 2 * wave + (ps >> 1))), hi = tr_rd(kb + img_off(32 * ks + 8 * g4 + 4 + q4, 2 * wave + (ps >> 1)));
            kf[ks] = mk8(lo, hi); } }
        asm volatile("s_waitcnt lgkmcnt(0)" ::: "memory");
        if (c < 15) asm volatile("s_waitcnt vmcnt(12)" ::: "memory"); else asm volatile("s_waitcnt vmcnt(0)" ::: "memory");
        __builtin_amdgcn_s_barrier(); asm volatile("" ::: "memory");
        float tvn = 0.f; if (c < 15) SC_TBLVAL(c + 1, tvn);
        { bf16* sp = SP + ((size_t)((b * 16 + c) * 8 + gi) * 8 + 2 * rp) * 64 * N + (RET ? nh * 128 : 0) + 16 * wave + nst;
#pragma unroll
          for (int rr = 0; rr < 2; ++rr)
#pragma unroll
            for (int pp = 0; pp < 2; ++pp) {
                v2u oe, oo; oe.x = pk2(acc[rr][2 * pp][0], acc[rr][2 * pp][1]); oe.y = pk2(acc[rr][2 * pp][2], acc[rr][2 * pp][3]);
                oo.x = pk2(acc[rr][2 * pp + 1][0], acc[rr][2 * pp + 1][1]); oo.y = pk2(acc[rr][2 * pp + 1][2], acc[rr][2 * pp + 1][3]);
                const unsigned sx = up ? oe.x : oo.x, sy = up ? oe.y : oo.y; const unsigned rx = (unsigned)__shfl_xor((int)sx, 32), ry = (unsigned)__shfl_xor((int)sy, 32);
                const v4u w = up ? (v4u){rx, ry, oo.x, oo.y} : (v4u){oe.x, oe.y, rx, ry};
                *(v4u*)(sp + (size_t)(rr * 64 + 16 * (2 * pp + (up ? 1 : 0)) + l15) * N) = w; } }
        if (c < 14) SC_STAGE_K(c + 2);
        LAS unsigned char* xb0 = lds + ((2 * c + 1) & 3) * 32768; LAS float* T = TBL + (c & 1) * 512;
#pragma unroll
        for (int rr = 0; rr < 2; ++rr) {
            const float dec = RET ? decR : T[256 + rr];
            bf16x8 kw[4];
#pragma unroll
            for (int ks = 0; ks < 4; ++ks) { float w[8];
                if (RET) {
#pragma unroll
                    for (int j = 0; j < 8; ++j) w[j] = wb[ks] * wj[j];
                } else { const f32x4 w0 = *(const LAS f32x4*)(T + rr * 128 + 32 * ks + 8 * g4), w1 = *(const LAS f32x4*)(T + rr * 128 + 32 * ks + 8 * g4 + 4);
                    w[0] = w0.x; w[1] = w0.y; w[2] = w0.z; w[3] = w0.w; w[4] = w1.x; w[5] = w1.y; w[6] = w1.z; w[7] = w1.w; }
                const v4u kv = __builtin_bit_cast(v4u, kf[ks]);
                kw[ks] = __builtin_bit_cast(bf16x8, (v4u){pk2(bflo(kv.x) * w[0], bfhi(kv.x) * w[1]), pk2(bflo(kv.y) * w[2], bfhi(kv.y) * w[3]), pk2(bflo(kv.z) * w[4], bfhi(kv.z) * w[5]), pk2(bflo(kv.w) * w[6], bfhi(kv.w) * w[7])}); }
#pragma unroll
            for (int pt = 0; pt < 4; ++pt) {
                f32x4 d = acc[rr][pt] * dec;
                LAS unsigned char* base = xb0 + 8 * (p4 & 1); const int cc = rr * 4 + pt;
#pragma unroll
                for (int ks = 0; ks < 4; ++ks) {
                    const s4v lo = tr_rd(base + img_off(32 * ks + 8 * g4 + q4, 2 * cc + (p4 >> 1))), hi = tr_rd(base + img_off(32 * ks + 8 * g4 + 4 + q4, 2 * cc + (p4 >> 1)));
                    d = MFMA16(kw[ks], mk8(lo, hi), d); }
                acc[rr][pt] = d; if (pt & 1) asm volatile("" ::: "memory"); }
        }
        if (!RET && c < 15 && tid < 258) TBL[((c + 1) & 1) * 512 + tid] = tvn;
        if (c < 14) asm volatile("s_waitcnt vmcnt(12)" ::: "memory"); else asm volatile("s_waitcnt vmcnt(0)" ::: "memory");
        asm volatile("s_waitcnt lgkmcnt(0)" ::: "memory");
        __builtin_amdgcn_s_barrier(); asm volatile("" ::: "memory");
    }
#undef SC_STAGE_K
#undef SC_STAGE_X
#undef SC_TBLVAL
    float* so = a.out + (RET ? O_RETP + ((size_t)(b * RH + gi) * RDV + rp * 128) * RDK + nh * 128 : O_SSMP + ((size_t)(b * NH + gi * 8 + 2 * rp) * 64) * NST) + 16 * wave + 4 * gs;
#pragma unroll
    for (int rr = 0; rr < 2; ++rr)
#pragma unroll
        for (int pt = 0; pt < 4; ++pt) *(f32x4*)(so + (size_t)(rr * 64 + 16 * pt + l15) * N) = acc[rr][pt];
}
__device__ __forceinline__ void scan_phase(const Args& a, LAS unsigned char* lds, int tid, int wave, int lane) {
    const int G = gridDim.x, vcu = (G % 8 == 0) ? (int)(blockIdx.x % 8) * (G / 8) + (int)(blockIdx.x / 8) : (int)blockIdx.x;
    for (int u = vcu; u < 256; u += G) scan_unit<true>(a, lds, u >> 6, (u >> 3) & 7, (u >> 1) & 3, u & 1, tid, wave, lane);
    for (int u = (vcu + 128) % G; u < 128; u += G) scan_unit<false>(a, lds, u >> 5, (u >> 2) & 7, u & 3, 0, tid, wave, lane);
}

template <bool RET> __device__ __forceinline__ void samp_stream(const Args& a, LAS unsigned char* lds, int tid, int wave, int lane, const int u0, const int ustride, const int nu) {
    constexpr int N = RET ? 256 : 128, NKS = N / 32, NSUB = N / 128, NTC = 2;
    constexpr int TSET = 28672;
    const bf16* PROJ = (const bf16*)(a.ws + WS_PROJ); const bf16* XBCA = (const bf16*)(a.ws + WS_XBCA);
    const float* DTV = (const float*)(a.ws + WS_DTV); const float* LA = (const float*)(a.ws + WS_LA);
    const bf16* Kb_ = RET ? PROJ : XBCA; const int nct = RET ? NCT_P : NCT_X;
    LAS float* SQ = (LAS float*)(lds + 2 * TSET); LAS float* YL = (LAS float*)(lds + 2 * TSET + 1024);
    const int g4 = lane >> 4, l15 = lane & 15, tt = l15 & 3;
    f32x4 cur[8], nxt[8];
    v4u tr[NTC]; float wv = 0.f;
#define TLOAD(bs_, gi_) do { const int Rs_ = NPR + (bs_) * SL; \
        _Pragma("unroll") for (int q_ = 0; q_ < NTC; ++q_) { const int k_ = tid + 512 * q_; int t_, col_; const bf16* src_ = Kb_; int nc_ = nct; \
            if (RET) { if (k_ < 128) { t_ = k_ >> 5; col_ = C_K + (gi_) * 256 + (k_ & 31) * 8; } else if (k_ < 256) { t_ = (k_ - 128) >> 5; col_ = C_Q + (gi_) * 256 + (k_ & 31) * 8; } else if (k_ < 512) { t_ = (k_ - 256) >> 6; col_ = C_V + (gi_) * 512 + (k_ & 63) * 8; } else { const int kk_ = k_ < 768 ? k_ - 512 : 0; t_ = kk_ >> 6; col_ = C_G + (gi_) * 512 + (kk_ & 63) * 8; } } \
            else { if (k_ < 64) { t_ = k_ >> 4; col_ = INNER + (gi_) * 128 + (k_ & 15) * 8; } else if (k_ < 128) { t_ = (k_ - 64) >> 4; col_ = INNER + NG * NST + (gi_) * 128 + (k_ & 15) * 8; } \
                   else if (k_ < 384) { t_ = (k_ - 128) >> 6; col_ = (gi_) * 512 + ((k_ - 128) & 63) * 8; } else { const int kk_ = k_ < 640 ? k_ - 384 : 0; t_ = kk_ >> 6; col_ = C_Z + (gi_) * 512 + (kk_ & 63) * 8; src_ = PROJ; nc_ = NCT_P; } } \
            tr[q_] = *(const v4u*)(src_ + toff(Rs_ + t_, col_, nc_)); } \
        if (lane < 8) { if (RET) wv = lane < 4 ? (float)(lane + 1) * logf(1.0f - exp2f(-5.0f - (float)(gi_))) : 1.0f; \
            else { const int h_ = (gi_) * 8 + wave; if (lane < 4) { wv = 0.f; for (int t2 = 0; t2 <= lane; ++t2) wv += LA[(size_t)(Rs_ + t2) * NH + h_]; } else wv = DTV[(size_t)(Rs_ + lane - 4) * NH + h_]; } } } while (0)
#define TWRITE(ts_) do { LAS unsigned char* tb_ = lds + (ts_) * TSET; \
        _Pragma("unroll") for (int q_ = 0; q_ < NTC; ++q_) { const int k_ = tid + 512 * q_; int off_ = -1; \
            if (RET) { if (k_ < 128) off_ = k_ * 32; else if (k_ < 256) off_ = 4096 + (k_ - 128) * 32; else if (k_ < 512) off_ = 8192 + (k_ - 256) * 32; else if (k_ < 768) off_ = 16384 + (k_ - 512) * 32; } \
            else { if (k_ < 64) off_ = k_ * 32; else if (k_ < 128) off_ = 4096 + (k_ - 64) * 32; else if (k_ < 384) off_ = 8192 + (k_ - 128) * 32; else if (k_ < 640) off_ = 16384 + (k_ - 384) * 32; } \
            if (off_ >= 0) { const v4u v_ = tr[q_]; *(LAS f32x4*)(tb_ + off_) = (f32x4){bflo(v_.x), bfhi(v_.x), bflo(v_.y), bfhi(v_.y)}; *(LAS f32x4*)(tb_ + off_ + 16) = (f32x4){bflo(v_.z), bfhi(v_.z), bflo(v_.w), bfhi(v_.w)}; } } \
        if (lane < 8) ((LAS float*)(tb_ + 24832))[wave * 8 + lane] = wv; } while (0)
#define SIN_OF(bs_, gi_) ((RET ? a.in[I_SRET] : a.in[I_SSSM]) + (RET ? ((size_t)((bs_) * RH + (gi_)) * RDV + wave * 64) : ((size_t)((bs_) * NH + (gi_) * 8 + wave) * 64)) * N)
#define SLOAD(dst, Sin_, j) do { const float* sp_ = (Sin_) + (size_t)(((j) / NSUB) * 16 + l15) * N + ((j) % NSUB) * 128 + 4 * g4; \
        _Pragma("unroll") for (int k_ = 0; k_ < 4; ++k_) { dst[2 * k_] = *(const f32x4*)(sp_ + 32 * k_); dst[2 * k_ + 1] = *(const f32x4*)(sp_ + 32 * k_ + 16); } } while (0)
    if (nu == 0) return;
    __syncthreads();
    { TLOAD(u0 >> 3, u0 & 7); TWRITE(0); SLOAD(cur, SIN_OF(u0 >> 3, u0 & 7), 0); }
    __syncthreads();
#pragma unroll 1
    for (int i = 0; i < nu; ++i) {
        const int u = u0 + i * ustride, bs = u >> 3, gi = u & 7, un = u + ustride, bsn = un >> 3, gin = un & 7; const bool more = i + 1 < nu;
        const size_t Rs = (size_t)NPR + (size_t)bs * SL;
        LAS unsigned char* tb = lds + (i & 1) * TSET;
        LAS float* BT = (LAS float*)tb; LAS float* CR = (LAS float*)(tb + 4096); LAS float* XT = (LAS float*)(tb + 8192); LAS float* ZT = (LAS float*)(tb + 16384);
        LAS float* CB = (LAS float*)(tb + 24576); LAS float* WSC = (LAS float*)(tb + 24832);
        const float* Sin = SIN_OF(bs, gi); float* Sout = a.out + (RET ? O_RETS : O_SSMS) + (Sin - (RET ? a.in[I_SRET] : a.in[I_SSSM]));
        for (int pp = wave; pp < 16; pp += 8) { const int t = pp >> 2, s = pp & 3; float d = 0.f; for (int n = lane; n < N; n += 64) d += CR[t * N + n] * BT[s * N + n]; d = wave_sum(d); if (lane == 0) CB[pp] = d; }
        __syncthreads();
        if (more) TLOAD(bsn, gin);
        const float acs_t = WSC[wave * 8 + tt], acs3 = WSC[wave * 8 + 3], A3 = __expf(acs3), At = __expf(acs_t);
        float cf[4], wd[4];
#pragma unroll
        for (int s = 0; s < 4; ++s) { const float as = WSC[wave * 8 + s], ds = WSC[wave * 8 + 4 + s]; cf[s] = (s <= tt) ? __expf(acs_t - as) * ds * CB[tt * 4 + s] : 0.f; wd[s] = __expf(acs3 - as) * ds; }
        const float Dh = RET ? 0.f : a.in[I_DSKIP][gi * 8 + wave];
        bf16x8 qf[NKS];
#pragma unroll
        for (int ks = 0; ks < NKS; ++ks) { const f32x4 c0 = *(const LAS f32x4*)(CR + tt * N + 32 * ks + 4 * g4), c1 = *(const LAS f32x4*)(CR + tt * N + 32 * ks + 16 + 4 * g4);
            const float m = l15 < 4 ? At : 0.f;
            qf[ks] = __builtin_bit_cast(bf16x8, (v4u){pk2(c0.x * m, c0.y * m), pk2(c0.z * m, c0.w * m), pk2(c1.x * m, c1.y * m), pk2(c1.z * m, c1.w * m)}); }
        float ssq = 0.f; f32x4 acc = (f32x4){0.f, 0.f, 0.f, 0.f};
#define SAMP_SUB(st, j) do { const int slab_ = (j) / NSUB, sub_ = (j) % NSUB, pu_ = 64 * wave + 16 * slab_; \
        float u_[4]; _Pragma("unroll") for (int s = 0; s < 4; ++s) u_[s] = wd[s] * XT[s * 512 + pu_ + l15]; \
        float* op_ = Sout + (size_t)(slab_ * 16 + l15) * N + sub_ * 128 + 4 * g4; \
        _Pragma("unroll") for (int k = 0; k < 4; ++k) { \
            const f32x4 s0 = st[2 * k], s1 = st[2 * k + 1]; \
            const bf16x8 af = __builtin_bit_cast(bf16x8, (v4u){pk2(s0.x, s0.y), pk2(s0.z, s0.w), pk2(s1.x, s1.y), pk2(s1.z, s1.w)}); \
            acc = MFMA16(af, (NSUB == 1 || sub_ == 0) ? qf[k] : qf[(NKS - 4) + k], acc); \
            f32x4 n0 = s0 * A3, n1 = s1 * A3; \
            _Pragma("unroll") for (int s = 0; s < 4; ++s) { const f32x4 b0 = *(const LAS f32x4*)(BT + s * N + sub_ * 128 + 32 * k + 4 * g4), b1 = *(const LAS f32x4*)(BT + s * N + sub_ * 128 + 32 * k + 16 + 4 * g4); \
                n0 += b0 * u_[s]; n1 += b1 * u_[s]; } \
            *(f32x4*)(op_ + 32 * k) = n0; *(f32x4*)(op_ + 32 * k + 16) = n1; } \
        if (sub_ == NSUB - 1) { \
            _Pragma("unroll") for (int i = 0; i < 4; ++i) { const int pc = pu_ + 4 * g4 + i; \
                float y = acc[i] + cf[0] * XT[pc] + cf[1] * XT[512 + pc] + cf[2] * XT[1024 + pc] + cf[3] * XT[1536 + pc]; \
                if (!RET) { y += Dh * XT[tt * 512 + pc]; const float z = ZT[tt * 512 + pc]; y *= siluf(z); } \
                if (l15 < 4) { YL[pc * 4 + tt] = y; ssq += y * y; } } \
            acc = (f32x4){0.f, 0.f, 0.f, 0.f}; } } while (0)
#pragma unroll 1
        for (int jp = 0; jp < 2 * NSUB; ++jp) {
            SLOAD(nxt, Sin, 2 * jp + 1);
            SAMP_SUB(cur, 2 * jp);
            if (jp + 1 < 2 * NSUB) SLOAD(cur, Sin, 2 * jp + 2);
            SAMP_SUB(nxt, 2 * jp + 1);
        }
        if (more) { SLOAD(cur, SIN_OF(bsn, gin), 0); TWRITE((i + 1) & 1); }
#undef SAMP_SUB
        ssq += __shfl_xor(ssq, 16); ssq += __shfl_xor(ssq, 32);
        if (lane < 4) SQ[wave * 4 + lane] = ssq;
        __syncthreads();
        float tot = 0.f;
#pragma unroll
        for (int w = 0; w < 8; ++w) tot += SQ[w * 4 + tt];
        const float rstd = 1.0f / sqrtf(tot * (1.0f / 512.0f) + EPS);
        if (wave == 0 && lane < 4) ((float*)(a.ws + WS_RSTD))[(Rs + lane) * 16 + (RET ? 8 : 0) + gi] = 1.0f;
        if (l15 < 4) {
            bf16* Yo = (bf16*)(a.ws + (RET ? WS_YR : WS_YS)) + (Rs + tt) * INNER + gi * 512;
#pragma unroll 1
            for (int slab = 0; slab < 4; ++slab) { const int pc = 64 * wave + 16 * slab + 4 * g4; float o[4];
#pragma unroll
                for (int i2 = 0; i2 < 4; ++i2) { o[i2] = YL[(pc + i2) * 4 + tt] * rstd;
                    if (RET) o[i2] *= siluf(ZT[tt * 512 + pc + i2]); else o[i2] *= a.in[I_SNW][gi * 512 + pc + i2]; }
                v2u ov; ov.x = pk2(o[0], o[1]); ov.y = pk2(o[2], o[3]); *(v2u*)(Yo + pc) = ov; }
        }
        __syncthreads();
    }
#undef TLOAD
#undef TWRITE
#undef SIN_OF
#undef SLOAD
}
__device__ __forceinline__ void scan_samp_phase(const Args& a, LAS unsigned char* lds, int tid, int wave, int lane) {
    const int G = gridDim.x;
    scan_phase(a, lds, tid, wave, lane);
    if (G == 256) {
        const int vcu = (int)(blockIdx.x % 8) * 32 + (int)(blockIdx.x / 8);
        samp_stream<true>(a, lds, tid, wave, lane, (int)blockIdx.x, G, 4);
        if (vcu < 128) samp_stream<false>(a, lds, tid, wave, lane, vcu, 128, 5); else samp_stream<false>(a, lds, tid, wave, lane, 640 + (vcu - 128), 128, 3);
    } else {
        const int nu = ((int)blockIdx.x < SB * 8) ? (SB * 8 - 1 - (int)blockIdx.x) / G + 1 : 0;
        samp_stream<true>(a, lds, tid, wave, lane, (int)blockIdx.x, G, nu); samp_stream<false>(a, lds, tid, wave, lane, (int)blockIdx.x, G, nu);
    }
}

#ifndef PROBE_DUP
#define PROBE_DUP 0
#endif
#ifndef MK_N_LAUNCHES
#define MK_N_LAUNCHES 1
#endif
constexpr int N_PHASES = 9;
template <int LO, int HI> __global__ void __launch_bounds__(NWAVES * 64, 2) fwd_kernel(Args args) {
    extern __shared__ __attribute__((aligned(16))) unsigned char lds_raw[];
    LAS unsigned char* lds = (LAS unsigned char*)lds_raw;
    const int tid = threadIdx.x, lane = tid & 63, wave = __builtin_amdgcn_readfirstlane(tid >> 6);
    const int G = gridDim.x;
    for (int u = tid; u < (LDS_BYTES - LDSCTL_OFF) / 4; u += NWAVES * 64) ((LAS unsigned*)(lds + LDSCTL_OFF))[u] = 0u;
    __syncthreads();
    unsigned* ctl = (unsigned*)(args.ws + WS_CTL);
    XcdBarrier bar; bar.bar = ctl + CW_BAR; bar.x = 0; bar.st = nullptr;
    constexpr int lo = LO, hi = HI;
    if (hi - lo > 1) bar = xcd_barrier_post(ctl + CW_BAR, (volatile LAS unsigned*)(lds + MISC_OFF) + 8);
#define IN(k) (lo <= (k) && (k) < hi)
#define IF_IN(k) if constexpr (IN(k))
#define SEAM(k) do { if constexpr (IN(k) && IN((k) + 1)) xcd_barrier(bar); } while (0)

#define PH_0 p0_prologue(args, lds, wave, lane)
#define PH_1 do { pg8::Gemm g{(const bf16*)(args.ws + WS_HN), (const bf16*)(args.ws + WS_WTIN), MT, LDP, DM, nullptr, nullptr}; pg8::StaticOrder S; S.init(MT, LDP, DM, G, (int)blockIdx.x); \
        pg8::EpiProj E{(bf16*)(args.ws + WS_PROJ), (float*)(args.ws + WS_DT), LDP, DT_TILE, (const float*)(args.ws + WS_COS), (const float*)(args.ws + WS_SIN), C_Q / 256, C_K / 256, NPR}; \
        pg8::gemm_phase<pg8::EpiProj, pg8::StaticOrder, true, true>(lds + RING_OFF, g, S, E); } while (0)
#define PH_2 p2_prep(args, lds)
#define PH_3 scan_samp_phase(args, lds, tid, wave, lane)
#define PH_4 passC(args.ws, args.in[I_DSKIP], args.in[I_SNW], lds)
#define PH_5 do { pg8::Gemm g{(const bf16*)(args.ws + WS_YS), (const bf16*)(args.ws + WS_WTPS), MT, DM, INNER, (const bf16*)(args.ws + WS_YR), (const bf16*)(args.ws + WS_WTPR)}; pg8::DualOrder S{G, (int)blockIdx.x}; \
        pg8::EpiDual E{(const bf16*)(args.ws + WS_PROJ), LDP, C_GATE, (bf16*)(args.ws + WS_MG), (float*)(args.ws + WS_MFS), NPR / 256, (const float*)(args.ws + WS_RSTD)}; \
        pg8::gemm_phase<pg8::EpiDual, pg8::DualOrder, true, true>(lds + RING_OFF, g, S, E); } while (0)
#define PH_6 p7_merge_sample(args)
#define PH_7 do { pg8::Gemm g{(const bf16*)(args.ws + WS_MG), (const bf16*)(args.ws + WS_WTO), MT, DM, DM, nullptr, nullptr}; pg8::OutOrder S{G, (int)blockIdx.x}; \
        pg8::EpiOut2 E{(float*)(args.ws + WS_OF), (float*)(args.ws + WS_OFS), NPR / 256}; \
        pg8::gemm_phase<pg8::EpiOut2, pg8::OutOrder, true, true>(lds + RING_OFF, g, S, E); } while (0)
#define PH_8 p8_final(args, wave, lane)
#ifndef SKIPMASK
#define SKIPMASK 0
#endif
#define RUN(k) do { IF_IN(k) { if constexpr (!(((SKIPMASK) >> (k)) & 1)) PH_##k; if constexpr ((MK_N_LAUNCHES == 1) && (((PROBE_DUP) >> (k)) & 1)) { xcd_barrier(bar); PH_##k; } } SEAM(k); } while (0)
    RUN(0); RUN(1); RUN(2); RUN(3); RUN(4); RUN(5); RUN(6); RUN(7); RUN(8);
#undef RUN
#undef IN
#undef IF_IN
#undef SEAM
}

template <int LO, int HI> static bool setup_one() { return hipFuncSetAttribute((const void*)fwd_kernel<LO, HI>, hipFuncAttributeMaxDynamicSharedMemorySize, LDS_BYTES) == hipSuccess; }
template <int LO, int HI> static void launch_one(int grid, hipStream_t stream, const Args& a) { hipLaunchKernelGGL((fwd_kernel<LO, HI>), dim3(grid), dim3(NWAVES * 64), LDS_BYTES, stream, a); }
#if MK_N_LAUNCHES == 1
static bool setup_all() { return setup_one<0, N_PHASES>(); }
static void launch_all(int grid, hipStream_t stream, const Args& a) { launch_one<0, N_PHASES>(grid, stream, a); }
#else
static bool setup_all() { return setup_one<0, 1>() && setup_one<1, 2>() && setup_one<2, 3>() && setup_one<3, 4>() && setup_one<4, 5>() && setup_one<5, 6>() && setup_one<6, 7>() && setup_one<7, 8>() && setup_one<8, 9>(); }
template <int K> static void launch_ph(int grid, hipStream_t stream, const Args& a) { launch_one<K, K + 1>(grid, stream, a); if ((PROBE_DUP >> K) & 1) launch_one<K, K + 1>(grid, stream, a); }
static void launch_all(int grid, hipStream_t stream, const Args& a) {
    launch_ph<0>(grid, stream, a); launch_ph<1>(grid, stream, a); launch_ph<2>(grid, stream, a); launch_ph<3>(grid, stream, a); launch_ph<4>(grid, stream, a);
    launch_ph<5>(grid, stream, a); launch_ph<6>(grid, stream, a); launch_ph<7>(grid, stream, a); launch_ph<8>(grid, stream, a); }
#endif
extern "C" void kernel_launch(void* const* d_in, const int* in_sizes, int n_in, void* d_out, int out_size, void* d_ws, size_t ws_size, hipStream_t stream) {
    static int grid = 0;
    if (grid == 0) {
        if (n_in != 17 || (size_t)out_size != O_END || ws_size < WS_END) { fprintf(stderr, "kernel_launch: unexpected shapes (n_in %d out %d ws %zu); nothing launched\n", n_in, out_size, ws_size); grid = -1; return; }
        int dev = 0, cus = 0, per_cu = 0;
        if (hipGetDevice(&dev) != hipSuccess || hipDeviceGetAttribute(&cus, hipDeviceAttributeMultiprocessorCount, dev) != hipSuccess) { grid = -1; return; }
        if (!setup_all()) { fprintf(stderr, "kernel_launch: hipFuncSetAttribute failed\n"); grid = -1; return; }
        (void)per_cu; (void)hipGetLastError();
        grid = cus;
    }
    if (grid < 0) return;
    if (hipMemsetAsync((char*)d_ws + WS_CTL, 0, CTL_ZERO_BYTES, stream) != hipSuccess) return;
    Args a{};
    for (int i = 0; i < 17; ++i) a.in[i] = (const float*)d_in[i];
    a.out = (float*)d_out; a.ws = (unsigned char*)d_ws;
    static_assert(sizeof(Args) == 160, "Args has no padding");
    a.ph_lo = 0; a.ph_hi = N_PHASES;
    launch_all(grid, stream, a);
}
#ifdef TEST_LO
template __global__ void fwd_kernel<TEST_LO, TEST_HI>(Args);
#endif
```
